# Optimizing an MI355X kernel written in HIP

```python
import math
import jax, jax.numpy as jnp
from jax import lax
import numpy as np

D_MODEL = 2048
BATCH = 32
SEQ = 256
DEPTH = 2
DEC_BATCH = 2
DEC_SEQ = 1024
PAST_LEN = 512

GRID_W = 64
N_MIXERS = 2
N_HEADS = 16
HEAD_DIM = D_MODEL // N_HEADS
NA_ROWS_MAX = 8
NA_COLS = 16
RPB_R = 2 * NA_ROWS_MAX - 1
RPB_C = 2 * NA_COLS - 1
S5_CH = 16
S5_GROUPS = D_MODEL // S5_CH
S5_P = 64
Q_BLOCK = 128
EPS = 1e-6
DT_MIN = 0.001
DT_MAX = 0.1

kernel_name = "hybrid_na_s5_prefix_denoise_step"


def _rmsnorm(x, g):
    xf = x.astype(jnp.float32)
    y = xf * lax.rsqrt(jnp.mean(xf * xf, axis=-1, keepdims=True) + EPS)
    return (y * g.astype(jnp.float32)).astype(x.dtype)


def _pre(x, cond, g, w_ada, b_ada):
    shift, scale, gate = jnp.split(jax.nn.silu(cond) @ w_ada + b_ada, 3, axis=-1)
    h = _rmsnorm(x, g) * (1 + scale) + shift
    return h, gate


def _na_proj(h, w_in):
    b, l, _ = h.shape
    q, k, v, z = jnp.split(h @ w_in, 4, axis=-1)
    shp = (b, l, N_HEADS, HEAD_DIM)
    return q.reshape(shp), k.reshape(shp), v.reshape(shp), z


def _ctx_attention(q, k, v):
    b, l, h, d = q.shape
    nblk = l // Q_BLOCK
    qb = jnp.moveaxis(q.reshape(b, nblk, Q_BLOCK, h, d), 1, 0)
    scale = HEAD_DIM ** -0.5

    def blk(qi):
        s = jnp.einsum("bqhd,bkhd->bhqk", qi, k).astype(jnp.float32) * scale
        p = jax.nn.softmax(s, axis=-1).astype(v.dtype)
        return jnp.einsum("bhqk,bkhd->bqhd", p, v)

    o = lax.map(blk, qb)
    return jnp.moveaxis(o, 0, 1).reshape(b, l, h, d)


def _latent_na(q, k, v, k_ctx, v_ctx, rpb):
    b, n, h, d = q.shape
    rows = n // GRID_W
    kr = min(NA_ROWS_MAX, rows)
    qg = q.reshape(b, rows, GRID_W, h, d)
    kg = k.reshape(b, rows, GRID_W, h, d)
    vg = v.reshape(b, rows, GRID_W, h, d)
    col = jnp.arange(GRID_W)
    c0 = jnp.clip(col - NA_COLS // 2, 0, GRID_W - NA_COLS)
    col_ok = (col[None, :] >= c0[:, None]) & (col[None, :] < c0[:, None] + NA_COLS)
    dc_idx = jnp.clip(col[None, :] - col[:, None] + NA_COLS - 1, 0, RPB_C - 1)
    scale = HEAD_DIM ** -0.5
    neg = jnp.float32(-1e30)

    def row_block(r):
        r0 = jnp.clip(r - kr // 2, 0, rows - kr)
        qr = lax.dynamic_index_in_dim(qg, r, axis=1, keepdims=False)
        kw = lax.dynamic_slice_in_dim(kg, r0, kr, axis=1)
        vw = lax.dynamic_slice_in_dim(vg, r0, kr, axis=1)
        dr_idx = r0 + jnp.arange(kr) - r + NA_ROWS_MAX - 1
        bias = rpb[:, dr_idx[:, None, None], dc_idx[None, :, :]]
        bias = jnp.transpose(bias, (0, 2, 1, 3)).astype(jnp.float32)
        s_loc = jnp.einsum("bqhd,bikhd->bhqik", qr, kw).astype(jnp.float32) * scale + bias[None]
        s_loc = jnp.where(col_ok[None, None, :, None, :], s_loc, neg)
        s_ctx = jnp.einsum("bqhd,bjhd->bhqj", qr, k_ctx).astype(jnp.float32) * scale
        s = jnp.concatenate([s_loc.reshape(b, h, GRID_W, kr * GRID_W), s_ctx], axis=-1)
        p = jax.nn.softmax(s, axis=-1).astype(v.dtype)
        p_loc = p[..., : kr * GRID_W].reshape(b, h, GRID_W, kr, GRID_W)
        p_ctx = p[..., kr * GRID_W:]
        return (jnp.einsum("bhqik,bikhd->bqhd", p_loc, vw)
                + jnp.einsum("bhqj,bjhd->bqhd", p_ctx, v_ctx))

    o = lax.map(row_block, jnp.arange(rows))
    return jnp.moveaxis(o, 0, 1).reshape(b, n, h, d)


def _na_out(x, o, z, gate, w_out):
    b, l = x.shape[:2]
    out = (o.reshape(b, l, D_MODEL) * jax.nn.silu(z)) @ w_out
    return x + gate * out


def _na_layer_ctx(x, c_ctx, p):
    g, w_ada, b_ada, w_in, rpb, w_out = p
    h, gate = _pre(x, c_ctx, g, w_ada, b_ada)
    q, k, v, z = _na_proj(h, w_in)
    o = _ctx_attention(q, k, v)
    return _na_out(x, o, z, gate, w_out), k, v


def _na_layer_lat(x, cond, k_ctx, v_ctx, p):
    g, w_ada, b_ada, w_in, rpb, w_out = p
    h, gate = _pre(x, cond, g, w_ada, b_ada)
    q, k, v, z = _na_proj(h, w_in)
    o = _latent_na(q, k, v, k_ctx, v_ctx, rpb)
    return _na_out(x, o, z, gate, w_out)


def _s5_discretise(a_re, a_im, log_dt, b_re, b_im):
    a_re = a_re.astype(jnp.float32)
    a_im = a_im.astype(jnp.float32)
    b_re = b_re.astype(jnp.float32)
    b_im = b_im.astype(jnp.float32)
    dt = jnp.exp(log_dt.astype(jnp.float32))[:, None]
    mag = jnp.exp(a_re * dt)
    ab_re = mag * jnp.cos(a_im * dt)
    ab_im = mag * jnp.sin(a_im * dt)
    den = a_re * a_re + a_im * a_im
    nr = ab_re - 1.0
    f_re = (nr * a_re + ab_im * a_im) / den
    f_im = (ab_im * a_re - nr * a_im) / den
    bb_re = f_re[..., None] * b_re - f_im[..., None] * b_im
    bb_im = f_re[..., None] * b_im + f_im[..., None] * b_re
    return ab_re, ab_im, bb_re, bb_im


def _complex_combine(e1, e2):
    a1r, a1i, b1r, b1i = e1
    a2r, a2i, b2r, b2i = e2
    return (a2r * a1r - a2i * a1i, a2r * a1i + a2i * a1r,
            a2r * b1r - a2i * b1i + b2r, a2r * b1i + a2i * b1r + b2i)


def _s5_scan(ug, a_re, a_im, log_dt, b_re, b_im, h0):
    ab_re, ab_im, bb_re, bb_im = _s5_discretise(a_re, a_im, log_dt, b_re, b_im)
    bu_re = jnp.einsum("blgc,gpc->blgp", ug, bb_re)
    bu_im = jnp.einsum("blgc,gpc->blgp", ug, bb_im)
    if h0 is not None:
        h0r, h0i = h0
        bu_re = bu_re.at[:, 0].add(ab_re * h0r - ab_im * h0i)
        bu_im = bu_im.at[:, 0].add(ab_re * h0i + ab_im * h0r)
    ar = jnp.broadcast_to(ab_re, bu_re.shape)
    ai = jnp.broadcast_to(ab_im, bu_re.shape)
    _, _, hr, hi = lax.associative_scan(_complex_combine, (ar, ai, bu_re, bu_im), axis=1)
    return hr, hi


def _s5_readout(hr, hi, c_re, c_im):
    return (jnp.einsum("blgp,gcp->blgc", hr, c_re.astype(jnp.float32))
            - jnp.einsum("blgp,gcp->blgc", hi, c_im.astype(jnp.float32)))


def _s5_layer(x, cond, p, init, return_state):
    (g, w_ada, b_ada, w_in, a_re, a_im, log_dt, b_re, b_im, c_re, c_im,
     d_skip, w_glu, b_glu, w_out) = p
    bsz, l, _ = x.shape
    h, gate = _pre(x, cond, g, w_ada, b_ada)
    u, z = jnp.split(h @ w_in, 2, axis=-1)
    uf = u.astype(jnp.float32)
    ug = uf.reshape(bsz, l, S5_GROUPS, S5_CH)
    if init is None:
        h0f, h0b = None, None
    else:
        st = init.astype(jnp.float32)
        h0f, h0b = (st[:, 0, 0], st[:, 0, 1]), (st[:, 1, 0], st[:, 1, 1])
    hfr, hfi = _s5_scan(ug, a_re[0], a_im[0], log_dt[0], b_re[0], b_im[0], h0f)
    hbr, hbi = _s5_scan(ug[:, ::-1], a_re[1], a_im[1], log_dt[1], b_re[1], b_im[1], h0b)
    y = _s5_readout(hfr, hfi, c_re[0], c_im[0]) + _s5_readout(hbr, hbi, c_re[1], c_im[1])[:, ::-1]
    y = y.reshape(bsz, l, D_MODEL) + d_skip.astype(jnp.float32) * uf
    y = jax.nn.gelu(y).astype(x.dtype)
    y = y * jax.nn.sigmoid(y @ w_glu + b_glu)
    out = (y * jax.nn.silu(z)) @ w_out
    x_new = x + gate * out
    if return_state:
        final = jnp.stack([jnp.stack([hfr[:, -1], hfi[:, -1]], axis=1),
                           jnp.stack([hbr[:, -1], hbi[:, -1]], axis=1)], axis=1)
        return x_new, final
    return x_new


def setup_inputs(seed: int = 0) -> dict:
    key = jax.random.key(seed)
    ks = jax.random.split(key, 32)
    f32 = jnp.float32
    d = D_MODEL
    sd = d ** -0.5

    def nrm(k, shape, s=1.0):
        return jax.random.normal(k, shape, f32) * s

    n_idx = jnp.arange(S5_P, dtype=f32)
    return {
        "x_prompt": nrm(ks[0], (BATCH, SEQ, d)),
        "x_sample": nrm(ks[1], (DEC_BATCH, DEC_SEQ, d)),
        "cache_l0_k": nrm(ks[2], (DEC_BATCH, PAST_LEN, N_HEADS, HEAD_DIM)),
        "cache_l0_v": nrm(ks[3], (DEC_BATCH, PAST_LEN, N_HEADS, HEAD_DIM)),
        "state_l1_s5": nrm(ks[4], (DEC_BATCH, 2, 2, S5_GROUPS, S5_P), 0.5),
        "c": nrm(ks[5], (DEC_BATCH, d)),
        "c_ctx": nrm(ks[6], (d,)),
        "l0_norm_g": 1.0 + nrm(ks[7], (d,), 0.1),
        "l0_w_ada": nrm(ks[8], (d, 3 * d), 0.5 * sd),
        "l0_b_ada": nrm(ks[9], (3 * d,), 0.01),
        "l0_w_in": nrm(ks[10], (d, 4 * d), sd),
        "l0_rpb": nrm(ks[11], (N_HEADS, RPB_R, RPB_C), 0.1),
        "l0_w_out": nrm(ks[12], (d, d), sd),
        "l1_norm_g": 1.0 + nrm(ks[13], (d,), 0.1),
        "l1_w_ada": nrm(ks[14], (d, 3 * d), 0.5 * sd),
        "l1_b_ada": nrm(ks[15], (3 * d,), 0.01),
        "l1_w_in": nrm(ks[16], (d, 2 * d), sd),
        "l1_a_re": -0.5 + nrm(ks[17], (2, S5_GROUPS, S5_P), 0.01),
        "l1_a_im": jnp.pi * n_idx + nrm(ks[18], (2, S5_GROUPS, S5_P), 0.01),
        "l1_log_dt": jax.random.uniform(ks[19], (2, S5_GROUPS), f32,
                                        minval=math.log(DT_MIN), maxval=math.log(DT_MAX)),
        "l1_b_re": nrm(ks[20], (2, S5_GROUPS, S5_P, S5_CH), (2.0 * S5_CH) ** -0.5),
        "l1_b_im": nrm(ks[21], (2, S5_GROUPS, S5_P, S5_CH), (2.0 * S5_CH) ** -0.5),
        "l1_c_re": nrm(ks[22], (2, S5_GROUPS, S5_CH, S5_P), (2.0 * S5_P) ** -0.5),
        "l1_c_im": nrm(ks[23], (2, S5_GROUPS, S5_CH, S5_P), (2.0 * S5_P) ** -0.5),
        "l1_d": nrm(ks[24], (d,)),
        "l1_w_glu": nrm(ks[25], (d, d), sd),
        "l1_b_glu": nrm(ks[26], (d,), 0.01),
        "l1_w_out": nrm(ks[27], (d, d), sd),
        "final_norm_g": 1.0 + nrm(ks[28], (d,), 0.1),
    }


def reference(x_prompt, x_sample, cache_l0_k, cache_l0_v, state_l1_s5, c, c_ctx,
              l0_norm_g, l0_w_ada, l0_b_ada, l0_w_in, l0_rpb, l0_w_out,
              l1_norm_g, l1_w_ada, l1_b_ada, l1_w_in, l1_a_re, l1_a_im, l1_log_dt,
              l1_b_re, l1_b_im, l1_c_re, l1_c_im, l1_d, l1_w_glu, l1_b_glu, l1_w_out,
              final_norm_g):
    params = [
        (l0_norm_g, l0_w_ada, l0_b_ada, l0_w_in, l0_rpb, l0_w_out),
        (l1_norm_g, l1_w_ada, l1_b_ada, l1_w_in, l1_a_re, l1_a_im, l1_log_dt,
         l1_b_re, l1_b_im, l1_c_re, l1_c_im, l1_d, l1_w_glu, l1_b_glu, l1_w_out),
    ]
    caches = [(cache_l0_k, cache_l0_v), (state_l1_s5,)]
    cond = c[:, None, :]
    yp, ys = x_prompt, x_sample
    new_state = []
    for i in range(DEPTH):
        if i % N_MIXERS == 0:
            yp, k_new, v_new = _na_layer_ctx(yp, c_ctx, params[i])
            ys = _na_layer_lat(ys, cond, caches[i][0], caches[i][1], params[i])
            new_state += [k_new, v_new]
        else:
            yp, st_new = _s5_layer(yp, c_ctx, params[i], None, True)
            ys = _s5_layer(ys, cond, params[i], caches[i][0], False)
            new_state.append(st_new)
    y_prompt = _rmsnorm(yp, final_norm_g)
    y_sample = _rmsnorm(ys, final_norm_g)
    new_k_l0, new_v_l0, new_state_l1 = new_state
    return (y_prompt, y_sample, new_k_l0, new_v_l0, new_state_l1)
```

```cpp
#include <hip/hip_runtime.h>
#include <cstdio>
#include <cstdint>

#ifndef MK_ONE_LAUNCH
#define MK_ONE_LAUNCH 1
#endif

namespace pg8 {
#define PG8_LAS __attribute__((address_space(3)))
typedef unsigned short bf16_t;
typedef short bf16x8 __attribute__((ext_vector_type(8)));
typedef float f32x4 __attribute__((ext_vector_type(4)));
typedef unsigned u32x4 __attribute__((ext_vector_type(4)));
constexpr int BM = 256, BK = 64, HALF = 128, HTB = HALF * BK * 2, STAGE_BYTES = 8 * HTB, NXCD = 8, WGM = 8;

__host__ __device__ __forceinline__ int lds_byte(int r, int c) { const int st = (r >> 4) * 2 + (c >> 5), rr = r & 15, cc = c & 31, ob = rr * 64 + cc * 2; return st * 1024 + (ob ^ (((ob >> 9) & 1) << 5)); }
__host__ __device__ __forceinline__ void stage_rc(int b, int& R, int& C) { const int st = b / 1024, sb = b % 1024, swz = sb ^ (((sb >> 9) & 1) << 5); R = (st >> 1) * 16 + swz / 64; C = (st & 1) * 32 + (swz % 64) / 2; }
__host__ __device__ __forceinline__ int perm32(int rho) { const int n = rho >> 4, i = rho & 15; return 8 * (i >> 2) + 4 * n + (i & 3); }

struct Unit { int pm, pn; };
struct Gemm { const bf16_t* A; const bf16_t* Bt; int M, N, K; };

struct StaticOrder {
    int nM, nN, nwg, G, c;
    __host__ __device__ void init(int M, int N, int G_, int c_) { nM = M / BM; nN = N / BM; nwg = nM * nN; G = G_; c = c_; }
    __host__ __device__ bool next(int i, Unit& u) const {
        const long L = (long)i * G + c; if (L >= nwg) return false;
        int wgid = (int)L; { const int q = nwg / NXCD, r = nwg % NXCD, xcd = wgid % NXCD, off = wgid / NXCD; wgid = (xcd < r ? xcd * (q + 1) : r * (q + 1) + (xcd - r) * q) + off; }
        const int nig = WGM * nN, gid = wgid / nig, fm = gid * WGM, gsz = (nM - fm) < WGM ? (nM - fm) : WGM;
        u.pm = fm + ((wgid % nig) % gsz); u.pn = (wgid % nig) / gsz; return true;
    }
    __device__ __forceinline__ void a_ready(const Unit&) const {}
    __device__ __forceinline__ void done(const Unit&) const {}
};

__device__ __forceinline__ unsigned cvt_pk_bf16(float lo, float hi) { unsigned r; asm volatile("v_cvt_pk_bf16_f32 %0, %1, %2" : "=v"(r) : "v"(lo), "v"(hi)); return r; }

template <class Epi, class Sched, bool ALIGN_EPI = false, bool SP2 = false>
__device__ __forceinline__ void gemm_phase(PG8_LAS unsigned char* lds, const Gemm g, const Sched& S, const Epi& E) {
    const int tid = threadIdx.x, wid = __builtin_amdgcn_readfirstlane(tid >> 6), lane = tid & 63, wr = wid >> 2, wc = wid & 3, fr = lane & 15, fq = lane >> 4;
    const int K = g.K, nt = K / BK;
    unsigned voffA[2], voffB[2];
#pragma unroll
    for (int i = 0; i < 2; ++i) { int R, C; stage_rc(tid * 16 + i * 8192, R, C); const int Rb = Epi::PERM ? ((R & ~31) + perm32(R & 31)) : R;
        voffA[i] = (unsigned)(R * K + C) * 2u; voffB[i] = (unsigned)(Rb * K + C) * 2u; }
    const size_t kstep = (size_t)(BK * 2);
    const size_t hstep = (size_t)HALF * K * 2;
    const size_t tstep = 2 * hstep;
    const unsigned ldsw = (unsigned)wid * 1024u;
    const int aoff = lds_byte(wr * 64 + fr, fq * 8), boff = lds_byte(wc * 32 + fr, fq * 8);
#define PG8_SA(b, h) (((b) * 2 + (h)) * HTB)
#define PG8_SB(b, h) ((4 + (b) * 2 + (h)) * HTB)
#define PG8_STAGE(bufoff, gbase, voff) do { _Pragma("unroll") for (int _i = 0; _i < 2; ++_i) \
        __builtin_amdgcn_global_load_lds((const unsigned*)((const char*)(gbase) + (voff)[_i]), (PG8_LAS unsigned*)(lds + (bufoff) + ldsw + _i * 8192), 16, 0, 0); } while (0)
#define PG8_LDA(dst, b, h) do { _Pragma("unroll") for (int m = 0; m < 4; ++m) _Pragma("unroll") for (int k = 0; k < 2; ++k) dst[m][k] = *(const PG8_LAS bf16x8*)(lds + PG8_SA(b, h) + aoff + m * 2048 + k * 1024); } while (0)
#define PG8_LDB(dst, b, h) do { _Pragma("unroll") for (int n = 0; n < 2; ++n) _Pragma("unroll") for (int k = 0; k < 2; ++k) dst[n][k] = *(const PG8_LAS bf16x8*)(lds + PG8_SB(b, h) + boff + n * 2048 + k * 1024); } while (0)
#define PG8_MMA(ai, bj, At, Bt) do { __builtin_amdgcn_s_setprio(1); _Pragma("unroll") for (int m = 0; m < 4; ++m) _Pragma("unroll") for (int n = 0; n < 2; ++n) _Pragma("unroll") for (int k = 0; k < 2; ++k) \
        acc[ai][bj][m][n] = __builtin_amdgcn_mfma_f32_16x16x32_bf16(Bt[n][k], At[m][k], acc[ai][bj][m][n], 0, 0, 0); __builtin_amdgcn_s_setprio(0); } while (0)
#define PG8_WAIT_V(n) asm volatile("s_waitcnt vmcnt(" #n ")" ::: "memory")
#define PG8_WAIT_L(n) asm volatile("s_waitcnt lgkmcnt(" #n ")" ::: "memory")
#define PG8_BAR __builtin_amdgcn_s_barrier()
#define PG8_SCHED __builtin_amdgcn_sched_barrier(0)
    Unit cur, nxt; int ui = 0;
    if (!S.next(0, cur)) return;
    f32x4 acc[2][2][4][2];
#pragma unroll
    for (int a = 0; a < 2; ++a)
#pragma unroll
        for (int b = 0; b < 2; ++b)
#pragma unroll
            for (int m = 0; m < 4; ++m)
#pragma unroll
                for (int n = 0; n < 2; ++n) acc[a][b][m][n] = (f32x4){0.f, 0.f, 0.f, 0.f};
    bf16x8 At[4][2], B0[2][2], B1[2][2];
    const char* cA = (const char*)g.A + (size_t)cur.pm * tstep; const char* cB = (const char*)g.Bt + (size_t)cur.pn * tstep;
    S.a_ready(cur);
    if constexpr (SP2) {
        PG8_STAGE(PG8_SB(0, 0), cB, voffB); PG8_STAGE(PG8_SB(0, 1), cB + hstep, voffB); PG8_STAGE(PG8_SA(0, 0), cA, voffA); PG8_STAGE(PG8_SA(0, 1), cA + hstep, voffA);
        if (wr == 1) PG8_BAR;
        PG8_WAIT_V(2); PG8_BAR;
        PG8_STAGE(PG8_SB(1, 0), cB + kstep, voffB); PG8_STAGE(PG8_SA(1, 0), cA + kstep, voffA); PG8_STAGE(PG8_SB(1, 1), cB + hstep + kstep, voffB);
        PG8_WAIT_V(6); PG8_BAR;
    } else {
        PG8_STAGE(PG8_SB(0, 0), cB, voffB); PG8_STAGE(PG8_SA(0, 0), cA, voffA); PG8_STAGE(PG8_SB(0, 1), cB + hstep, voffB); PG8_STAGE(PG8_SA(0, 1), cA + hstep, voffA);
        if (wr == 1) PG8_BAR;
        PG8_WAIT_V(4); PG8_BAR;
        PG8_STAGE(PG8_SB(1, 0), cB + kstep, voffB); PG8_STAGE(PG8_SA(1, 0), cA + kstep, voffA); PG8_STAGE(PG8_SB(1, 1), cB + hstep + kstep, voffB);
        PG8_WAIT_V(6); PG8_BAR;
    }
    for (;;) {
        const bool has_next = S.next(ui + 1, nxt);
        const char* nA = has_next ? (const char*)g.A + (size_t)nxt.pm * tstep : cA; const char* nB = has_next ? (const char*)g.Bt + (size_t)nxt.pn * tstep : cB;
        for (int t = 0; t < nt; t += 2) {
            const bool last = (t == nt - 2);
            const char* a1 = cA + (size_t)(t + 1) * kstep;
            const char* a2 = last ? nA : cA + (size_t)(t + 2) * kstep; const char* b2 = last ? nB : cB + (size_t)(t + 2) * kstep;
            const char* a3 = a2 + kstep; const char* b3 = b2 + kstep;
            if (last && has_next) S.a_ready(nxt);
            if constexpr (SP2) {
            PG8_LDB(B0, 0, 0); PG8_LDB(B1, 0, 1); PG8_SCHED; PG8_LDA(At, 0, 0); PG8_STAGE(PG8_SA(1, 1), a1 + hstep, voffA);
            PG8_WAIT_V(8); PG8_WAIT_L(0); PG8_BAR; PG8_MMA(0, 0, At, B0); PG8_MMA(0, 1, At, B1); PG8_BAR; PG8_SCHED;
            PG8_LDA(At, 0, 1); PG8_STAGE(PG8_SB(0, 0), b2, voffB); PG8_STAGE(PG8_SB(0, 1), b2 + hstep, voffB); PG8_STAGE(PG8_SA(0, 0), a2, voffA);
            PG8_WAIT_V(8); PG8_WAIT_L(0); PG8_BAR; PG8_MMA(1, 0, At, B0); PG8_MMA(1, 1, At, B1); PG8_BAR; PG8_SCHED;
            PG8_LDB(B0, 1, 0); PG8_LDB(B1, 1, 1); PG8_SCHED; PG8_LDA(At, 1, 0); PG8_STAGE(PG8_SA(0, 1), a2 + hstep, voffA);
            PG8_WAIT_V(8); PG8_WAIT_L(0); PG8_BAR; PG8_MMA(0, 0, At, B0); PG8_MMA(0, 1, At, B1); PG8_BAR; PG8_SCHED;
            PG8_LDA(At, 1, 1); PG8_STAGE(PG8_SB(1, 0), b3, voffB); PG8_STAGE(PG8_SB(1, 1), b3 + hstep, voffB); PG8_STAGE(PG8_SA(1, 0), a3, voffA);
            PG8_WAIT_V(8); PG8_WAIT_L(0); PG8_BAR; PG8_MMA(1, 0, At, B0); PG8_MMA(1, 1, At, B1); PG8_BAR; PG8_SCHED;
            } else {
            PG8_LDB(B0, 0, 0); PG8_SCHED; PG8_LDA(At, 0, 0); PG8_STAGE(PG8_SA(1, 1), a1 + hstep, voffA);
            PG8_WAIT_L(8); PG8_BAR; PG8_WAIT_L(0); PG8_MMA(0, 0, At, B0); PG8_BAR; PG8_SCHED;
            PG8_LDB(B1, 0, 1); PG8_STAGE(PG8_SB(0, 0), b2, voffB);
            PG8_BAR; PG8_WAIT_L(0); PG8_MMA(0, 1, At, B1); PG8_BAR;
            PG8_LDA(At, 0, 1); PG8_STAGE(PG8_SA(0, 0), a2, voffA);
            PG8_BAR; PG8_WAIT_L(0); PG8_MMA(1, 0, At, B0); PG8_BAR; PG8_SCHED;
            PG8_STAGE(PG8_SB(0, 1), b2 + hstep, voffB);
            PG8_WAIT_V(6); PG8_BAR; PG8_MMA(1, 1, At, B1); PG8_BAR;
            PG8_LDB(B0, 1, 0); PG8_SCHED; PG8_LDA(At, 1, 0); PG8_STAGE(PG8_SA(0, 1), a2 + hstep, voffA);
            PG8_WAIT_L(8); PG8_BAR; PG8_WAIT_L(0); PG8_MMA(0, 0, At, B0); PG8_BAR; PG8_SCHED;
            PG8_LDB(B1, 1, 1); PG8_STAGE(PG8_SB(1, 0), b3, voffB);
            PG8_BAR; PG8_WAIT_L(0); PG8_MMA(0, 1, At, B1); PG8_BAR;
            PG8_LDA(At, 1, 1); PG8_STAGE(PG8_SA(1, 0), a3, voffA);
            PG8_BAR; PG8_WAIT_L(0); PG8_MMA(1, 0, At, B0); PG8_BAR; PG8_SCHED;
            PG8_STAGE(PG8_SB(1, 1), b3 + hstep, voffB);
            PG8_WAIT_V(6); PG8_BAR; PG8_MMA(1, 1, At, B1); PG8_BAR;
            }
        }
        if constexpr (ALIGN_EPI) { if (wr == 0) PG8_BAR; }
        E(acc, cur, wr, wc, fr, fq); S.done(cur);
        if (!has_next) break;
#pragma unroll
        for (int a = 0; a < 2; ++a)
#pragma unroll
            for (int b = 0; b < 2; ++b)
#pragma unroll
                for (int m = 0; m < 4; ++m)
#pragma unroll
                    for (int n = 0; n < 2; ++n) acc[a][b][m][n] = (f32x4){0.f, 0.f, 0.f, 0.f};
        cur = nxt; cA = nA; cB = nB; ++ui;
        if constexpr (ALIGN_EPI) { if (wr == 1) PG8_BAR; }
    }
    PG8_WAIT_V(0);
    if constexpr (!ALIGN_EPI) { if (wr == 0) PG8_BAR; }
    PG8_BAR;
#undef PG8_SA
#undef PG8_SB
#undef PG8_STAGE
#undef PG8_LDA
#undef PG8_LDB
#undef PG8_MMA
#undef PG8_WAIT_V
#undef PG8_WAIT_L
#undef PG8_BAR
#undef PG8_SCHED
}
}

constexpr int NWAVES = 8;
constexpr int DM = 2048;
constexpr int MP = 8192, MS = 2048, MT = MP + MS;
constexpr int NH = 16, HD = 128;
constexpr float EPS = 1e-6f;
constexpr int N_IN = 29;
constexpr int NPHASE = 11;

constexpr size_t OUT_Y = 0, OUT_NK = (size_t)MT * DM, OUT_NV = OUT_NK + (size_t)MP * DM, OUT_ST = OUT_NV + (size_t)MP * DM;

constexpr size_t MiB = 1u << 20;
constexpr size_t WS_CTL = 0, CTL_ZERO_BYTES = 1 * MiB;
constexpr size_t WS_ADA = 1 * MiB;
constexpr size_t WS_W1 = 2 * MiB;
constexpr size_t WS_W2 = WS_W1 + 32 * MiB;
constexpr size_t WS_W3 = WS_W2 + 8 * MiB;
constexpr size_t WS_W4 = WS_W3 + 16 * MiB;
constexpr size_t WS_W5 = WS_W4 + 8 * MiB;
constexpr size_t WS_CK = WS_W5 + 8 * MiB;
constexpr size_t WS_CV = WS_CK + 4 * MiB;
constexpr size_t WS_S5B = WS_CV + 4 * MiB;
constexpr size_t WS_S5C = WS_S5B + 1 * MiB;
constexpr size_t WS_S5A = WS_S5C + 1 * MiB;
constexpr size_t WS_ACTA = WS_S5A + 1 * MiB;
constexpr size_t ACT_BYTES = (size_t)MT * DM * 2;
constexpr size_t WS_QB = WS_ACTA + ACT_BYTES;
constexpr size_t WS_KB = WS_QB + ACT_BYTES;
constexpr size_t WS_VB = WS_KB + ACT_BYTES;
constexpr size_t WS_SZ = WS_VB + ACT_BYTES;
constexpr size_t WS_END = WS_SZ + ACT_BYTES;
constexpr int CW_QUEUE = 64;
constexpr int CW_QATT = 128, CW_QS5 = 192;
constexpr int CW_BAR = 4096;

constexpr int RING_BYTES = 131072;
constexpr int MISC_OFF = RING_BYTES + 320;
constexpr int LDS_BYTES = 147456;

#define GAS __attribute__((address_space(1)))
#define LAS __attribute__((address_space(3)))
typedef unsigned short bf16;
typedef unsigned v4u __attribute__((ext_vector_type(4)));
typedef unsigned v2u __attribute__((ext_vector_type(2)));
typedef float f32x4 __attribute__((ext_vector_type(4)));
typedef short bf16x8 __attribute__((ext_vector_type(8)));
typedef GAS unsigned gu32;
#define RLX_AGENT __ATOMIC_RELAXED, __HIP_MEMORY_SCOPE_AGENT
#define LDS_WAIT() asm volatile("s_waitcnt lgkmcnt(0)" ::: "memory")
#define VM_WAIT() asm volatile("s_waitcnt vmcnt(0)" ::: "memory")
__device__ __forceinline__ unsigned f2bf(float f) { unsigned u = __builtin_bit_cast(unsigned, f); return (u + 0x7fffu + ((u >> 16) & 1u)) >> 16; }
__device__ __forceinline__ unsigned pk2(float lo, float hi) { return pg8::cvt_pk_bf16(lo, hi); }
__device__ __forceinline__ float bf2f(unsigned short b) { return __builtin_bit_cast(float, (unsigned)b << 16); }
__device__ __forceinline__ float siluf(float v) { return v / (1.f + __expf(-v)); }

#define XB_TMO      128
#define XB_XCNT(j)  (256  + 64 * (j))
#define XB_XSUB(j)  (1280 + 64 * (j))
#define XB_XGEN(j)  (2304 + 64 * (j))
#define XB_TOP      3328
#define XB_TOPGEN   3392
#define XCD_BAR_WORDS 3456
#define XB_SPIN_CAP (1u << 18)
__device__ __forceinline__ unsigned xb_ld(unsigned* p)              { return __hip_atomic_load(p, __ATOMIC_RELAXED, __HIP_MEMORY_SCOPE_AGENT); }
__device__ __forceinline__ unsigned xb_add(unsigned* p, unsigned v) { return __hip_atomic_fetch_add(p, v, __ATOMIC_RELAXED, __HIP_MEMORY_SCOPE_AGENT); }
__device__ __forceinline__ unsigned xb_xcc_id() { return (unsigned)__builtin_amdgcn_s_getreg((3 << 11) | 20) & 0xFu; }
#define XB_SPIN(cond, bar) do { unsigned _sp = 0; while (cond) { __builtin_amdgcn_s_sleep(1); \
    if ((++_sp & 255u) == 0u) { if (xb_ld(&(bar)[XB_TMO])) break; if (_sp > XB_SPIN_CAP) { atomicAdd(&(bar)[XB_TMO], 1u); break; } } } } while (0)
struct XcdBarrier { unsigned* bar; unsigned x; volatile LAS unsigned* st; };
__device__ __forceinline__ XcdBarrier xcd_barrier_post(unsigned* bar, volatile LAS unsigned* st) {
    XcdBarrier b; b.bar = bar; b.x = xb_xcc_id(); b.st = st;
    if (threadIdx.x == 0) (void)xb_add(&bar[XB_XCNT(b.x)], 1u);
    return b;
}
__device__ __forceinline__ void xcd_barrier_complete(unsigned* bar, unsigned x, unsigned& nloc, unsigned& nx) {
    const unsigned G = gridDim.x * gridDim.y * gridDim.z;
    unsigned sum, cnt, mine, sp = 0u;
    for (;;) {
        sum = 0u; cnt = 0u; mine = 0u;
#pragma unroll
        for (unsigned j = 0; j < 16; ++j) { const unsigned c = xb_ld(&bar[XB_XCNT(j)]); sum += c; cnt += (c > 0u) ? 1u : 0u; mine = (j == x) ? c : mine; }
        if (sum == G) break;
        __builtin_amdgcn_s_sleep(1);
        if ((++sp & 255u) == 0u) { if (xb_ld(&bar[XB_TMO])) break; if (sp > XB_SPIN_CAP) { atomicAdd(&bar[XB_TMO], 1u); break; } }
    }
    nloc = mine > 0u ? mine : 1u; nx = cnt > 0u ? cnt : 1u;
}
__device__ __forceinline__ void xcd_barrier(const XcdBarrier& b) {
    asm volatile("s_waitcnt vmcnt(0)" ::: "memory");
    __syncthreads();
    if (threadIdx.x == 0) {
        unsigned* bar = b.bar;
        __builtin_amdgcn_s_waitcnt(0);
        unsigned nloc = b.st[0], nx = b.st[1];
        if (nloc == 0u) { xcd_barrier_complete(bar, b.x, nloc, nx); b.st[0] = nloc; b.st[1] = nx; }
        const unsigned old = xb_add(&bar[XB_XSUB(b.x)], 1u);
        const unsigned gen = old / nloc;
        if (old + 1u == (gen + 1u) * nloc) {
            __builtin_amdgcn_fence(__ATOMIC_RELEASE, "agent");
            asm volatile("s_waitcnt vmcnt(0)" ::: "memory");
            const unsigned og = xb_add(&bar[XB_TOP], 1u);
            const unsigned tg = og / nx;
            if (og + 1u == (tg + 1u) * nx) xb_add(&bar[XB_TOPGEN], 1u);
            else XB_SPIN(xb_ld(&bar[XB_TOPGEN]) == tg, bar);
            __builtin_amdgcn_fence(__ATOMIC_ACQUIRE, "agent");
            xb_add(&bar[XB_XGEN(b.x)], 1u);
            asm volatile("s_waitcnt vmcnt(0)" ::: "memory");
        } else {
            XB_SPIN(xb_ld(&bar[XB_XGEN(b.x)]) == gen, bar);
            __builtin_amdgcn_fence(__ATOMIC_ACQUIRE, "agent");
            asm volatile("s_waitcnt vmcnt(0)" ::: "memory");
        }
    }
    __syncthreads();
}

struct Args { const float* in[N_IN]; float* out; unsigned char* ws; int ph_lo, ph_hi; };

struct Frame {
    LAS unsigned char* lds;
    int tid, lane, wave, bid, G;
    const float* const* in;
    float* out; unsigned char* ws;
};

__device__ __forceinline__ float wave_sum(float v) {
#pragma unroll
    for (int o = 1; o < 64; o <<= 1) v += __shfl_xor(v, o);
    return v;
}
__device__ __forceinline__ const float* xrow_ptr(const Frame& F, int m) {
    return m < MP ? F.in[0] + (size_t)m * DM : F.in[1] + (size_t)(m - MP) * DM;
}
__device__ __forceinline__ int row_cond(int m) { return m < MP ? 0 : 1 + ((m - MP) >> 10); }

__device__ __forceinline__ void p0_transpose_item(const float* W, int K, int N, bf16* WT, LAS float* scr, int item, int lane) {
    const int nblk = N / 32, kb = item / nblk, nb = item % nblk, k0 = 64 * kb, n0 = 32 * nb;
#pragma unroll 8
    for (int i = 0; i < 32; ++i) { const int kk = 2 * i + (lane >> 5); scr[kk * 33 + (lane & 31)] = W[(size_t)(k0 + kk) * N + n0 + (lane & 31)]; }
    LDS_WAIT(); asm volatile("" ::: "memory");
    const int c = lane & 7;
#pragma unroll
    for (int j = 0; j < 4; ++j) { const int n = (lane >> 3) + 8 * j; const LAS float* s = scr + (8 * c) * 33 + n;
        v4u o; o.x = pk2(s[0 * 33], s[1 * 33]); o.y = pk2(s[2 * 33], s[3 * 33]); o.z = pk2(s[4 * 33], s[5 * 33]); o.w = pk2(s[6 * 33], s[7 * 33]);
        *(GAS v4u*)(WT + (size_t)(n0 + n) * K + k0 + 8 * c) = o; }
    LDS_WAIT(); asm volatile("" ::: "memory");
}

__device__ __forceinline__ void p0_ada_item(Frame& F, int item) {
    LAS float* sc = (LAS float*)F.lds;
    LAS float* red = sc + 3 * 2048;
    const int l = item / 96, cb = item % 96;
    for (int i = F.tid; i < 3 * 2048; i += NWAVES * 64) { const int c = i >> 11, k = i & 2047; const float v = (c == 0) ? F.in[6][k] : F.in[5][(c - 1) * 2048 + k]; sc[i] = siluf(v); }
    __syncthreads();
    const float* W = F.in[l ? 14 : 8]; const float* bias = F.in[l ? 15 : 9];
    const int col = cb * 64 + F.lane, k0 = F.wave * 256;
    float a0 = 0.f, a1 = 0.f, a2 = 0.f;
    for (int k = 0; k < 256; k += 8) {
        float w[8];
#pragma unroll
        for (int i = 0; i < 8; ++i) w[i] = W[(size_t)(k0 + k + i) * 6144 + col];
#pragma unroll
        for (int i = 0; i < 8; ++i) { a0 += sc[k0 + k + i] * w[i]; a1 += sc[2048 + k0 + k + i] * w[i]; a2 += sc[4096 + k0 + k + i] * w[i]; }
    }
    red[(F.wave * 3 + 0) * 64 + F.lane] = a0; red[(F.wave * 3 + 1) * 64 + F.lane] = a1; red[(F.wave * 3 + 2) * 64 + F.lane] = a2;
    __syncthreads();
    if (F.tid < 192) { const int c = F.tid >> 6, ln = F.tid & 63; float s = bias[cb * 64 + ln];
#pragma unroll
        for (int w = 0; w < 8; ++w) s += red[(w * 3 + c) * 64 + ln];
        ((float*)(F.ws + WS_ADA))[(l * 3 + c) * 6144 + cb * 64 + ln] = s; }
    __syncthreads();
}

__device__ __forceinline__ void s5_precompute_hook(Frame& F);
__device__ __forceinline__ void p0_prologue(Frame& F) {
    if (F.bid < 192) p0_ada_item(F, F.bid);
    s5_precompute_hook(F);
    { const int gt = F.bid * (NWAVES * 64) + F.tid, NT = F.G * NWAVES * 64;
      for (int i = gt; i < 2 * (2 * 512 * 2048 / 8); i += NT) { const int which = i >= (2 * 512 * 2048 / 8); const int j = which ? i - (2 * 512 * 2048 / 8) : i;
          const float* src = F.in[which ? 3 : 2] + (size_t)j * 8; const f32x4 a = *(const f32x4*)src, b = *(const f32x4*)(src + 4);
          v4u o; o.x = pk2(a.x, a.y); o.y = pk2(a.z, a.w); o.z = pk2(b.x, b.y); o.w = pk2(b.z, b.w);
          *(v4u*)((bf16*)(F.ws + (which ? WS_CV : WS_CK)) + (size_t)j * 8) = o; } }
    LAS float* scr = (LAS float*)(F.lds + F.wave * 16384);
    constexpr int I1 = (DM / 64) * (8192 / 32), I2 = (DM / 64) * (2048 / 32), I3 = (DM / 64) * (4096 / 32);
    constexpr int NITEMS = I1 + I2 + I3 + I2 + I2;
    unsigned* q = (unsigned*)(F.ws + WS_CTL) + CW_QUEUE;
    for (;;) {
        int it = 0; if (F.lane == 0) it = (int)__hip_atomic_fetch_add(q, 1u, RLX_AGENT); it = __builtin_amdgcn_readfirstlane(it);
        if (it >= NITEMS) break;
        int r = it;
        if (r < I1) { p0_transpose_item(F.in[10], DM, 8192, (bf16*)(F.ws + WS_W1), scr, r, F.lane); continue; } r -= I1;
        if (r < I2) { p0_transpose_item(F.in[12], DM, 2048, (bf16*)(F.ws + WS_W2), scr, r, F.lane); continue; } r -= I2;
        if (r < I3) { p0_transpose_item(F.in[16], DM, 4096, (bf16*)(F.ws + WS_W3), scr, r, F.lane); continue; } r -= I3;
        if (r < I2) { p0_transpose_item(F.in[25], DM, 2048, (bf16*)(F.ws + WS_W4), scr, r, F.lane); continue; } r -= I2;
        p0_transpose_item(F.in[27], DM, 2048, (bf16*)(F.ws + WS_W5), scr, r, F.lane);
    }
}

template <bool FROM_INPUT>
__device__ __forceinline__ void norm_mod_rows(Frame& F, const float* xsrc, const float* g, const float* ada  , bf16* dst) {
    const int gw = F.bid * NWAVES + F.wave, NGW = F.G * NWAVES;
    for (int m = gw; m < MT; m += NGW) {
        const float* xr = FROM_INPUT ? xrow_ptr(F, m) : xsrc + (size_t)m * DM;
        const float* ad = ada + row_cond(m) * 6144;
        f32x4 v[8]; float s = 0.f;
#pragma unroll
        for (int j = 0; j < 8; ++j) { v[j] = *(const f32x4*)(xr + 4 * F.lane + 256 * j); s += (v[j].x * v[j].x + v[j].y * v[j].y) + (v[j].z * v[j].z + v[j].w * v[j].w); }
        const float rstd = 1.0f / sqrtf(wave_sum(s) * (1.f / DM) + EPS);
#pragma unroll
        for (int j = 0; j < 8; ++j) { const int c = 4 * F.lane + 256 * j;
            const f32x4 gg = *(const f32x4*)(g + c), sh = *(const f32x4*)(ad + c), sc = *(const f32x4*)(ad + 2048 + c);
            const f32x4 o = (v[j] * rstd) * gg * (sc + 1.0f) + sh;
            v2u w; w.x = pk2(o.x, o.y); w.y = pk2(o.z, o.w);
            *(v2u*)(dst + (size_t)m * DM + c) = w; }
    }
}

struct EpiL0In {
    static constexpr bool PERM = true;
    bf16 *QB, *KB, *VB, *SZ; float *outK, *outV; float qscale;
    __device__ __forceinline__ void operator()(const pg8::f32x4 (&acc)[2][2][4][2], const pg8::Unit& u, int wr, int wc, int fr, int fq) const {
        const int sec = u.pn >> 3, colt = (u.pn & 7) * 256;
        const int row0 = u.pm * 256 + wr * 64 + fr, col0 = colt + wc * 32 + 8 * fq;
        bf16* base = sec == 0 ? QB : sec == 1 ? KB : sec == 2 ? VB : SZ;
        float* fout = sec == 1 ? outK : outV;
        const bool wr32 = (sec == 1 || sec == 2) && (u.pm * 256 < MP);
#pragma unroll
        for (int ai = 0; ai < 2; ++ai)
#pragma unroll
            for (int m = 0; m < 4; ++m) { const size_t ro = (size_t)(row0 + ai * 128 + m * 16) * DM + col0;
#pragma unroll
                for (int bj = 0; bj < 2; ++bj) { f32x4 v0 = acc[ai][bj][m][0], v1 = acc[ai][bj][m][1];
                    if (wr32) { *(f32x4*)(fout + ro + bj * 128) = v0; *(f32x4*)(fout + ro + bj * 128 + 4) = v1; }
                    if (sec == 0) { v0 = v0 * qscale; v1 = v1 * qscale; }
                    if (sec == 3) {
#pragma unroll
                        for (int j = 0; j < 4; ++j) { v0[j] = siluf(v0[j]); v1[j] = siluf(v1[j]); } }
                    v4u w; w.x = pk2(v0[0], v0[1]); w.y = pk2(v0[2], v0[3]); w.z = pk2(v1[0], v1[1]); w.w = pk2(v1[2], v1[3]);
                    *(v4u*)(base + ro + bj * 128) = w; } }
    }
};

template <bool FROM_INPUT>
struct EpiResid {
    static constexpr bool PERM = true;
    const float* xp; const float* xs; float* xo; const float* gate3;
    __device__ __forceinline__ void operator()(const pg8::f32x4 (&acc)[2][2][4][2], const pg8::Unit& u, int wr, int wc, int fr, int fq) const {
        const int rowt = u.pm * 256, row0 = rowt + wr * 64 + fr, col0 = u.pn * 256 + wc * 32 + 8 * fq;
        const float* gv = gate3 + row_cond(rowt) * 6144 + 4096 + col0;
        f32x4 g4[2][2];
#pragma unroll
        for (int bj = 0; bj < 2; ++bj) { g4[bj][0] = *(const f32x4*)(gv + bj * 128); g4[bj][1] = *(const f32x4*)(gv + bj * 128 + 4); }
#pragma unroll
        for (int ai = 0; ai < 2; ++ai)
#pragma unroll
            for (int m = 0; m < 4; ++m) { const int row = row0 + ai * 128 + m * 16; const size_t ro = (size_t)row * DM + col0;
                const float* xin = FROM_INPUT ? (row < MP ? xp + ro : xs + (ro - (size_t)MP * DM)) : xo + ro;
#pragma unroll
                for (int bj = 0; bj < 2; ++bj) { const f32x4 x0 = *(const f32x4*)(xin + bj * 128), x1 = *(const f32x4*)(xin + bj * 128 + 4);
                    *(f32x4*)(xo + ro + bj * 128) = x0 + g4[bj][0] * acc[ai][bj][m][0]; *(f32x4*)(xo + ro + bj * 128 + 4) = x1 + g4[bj][1] * acc[ai][bj][m][1]; } }
    }
};
struct EpiL1In {
    static constexpr bool PERM = true;
    bf16 *UB, *SZ1;
    __device__ __forceinline__ void operator()(const pg8::f32x4 (&acc)[2][2][4][2], const pg8::Unit& u, int wr, int wc, int fr, int fq) const {
        const int sec = u.pn >> 3, colt = (u.pn & 7) * 256;
        const int row0 = u.pm * 256 + wr * 64 + fr, col0 = colt + wc * 32 + 8 * fq;
        bf16* base = sec == 0 ? UB : SZ1;
#pragma unroll
        for (int ai = 0; ai < 2; ++ai)
#pragma unroll
            for (int m = 0; m < 4; ++m) { const size_t ro = (size_t)(row0 + ai * 128 + m * 16) * DM + col0;
#pragma unroll
                for (int bj = 0; bj < 2; ++bj) { f32x4 v0 = acc[ai][bj][m][0], v1 = acc[ai][bj][m][1];
                    if (sec == 1) {
#pragma unroll
                        for (int j = 0; j < 4; ++j) { v0[j] = siluf(v0[j]); v1[j] = siluf(v1[j]); } }
                    v4u w; w.x = pk2(v0[0], v0[1]); w.y = pk2(v0[2], v0[3]); w.z = pk2(v1[0], v1[1]); w.w = pk2(v1[2], v1[3]);
                    *(v4u*)(base + ro + bj * 128) = w; } }
    }
};
struct EpiGlu {
    static constexpr bool PERM = true;
    const bf16 *YG, *SZ1; const float* bglu; bf16* Y2;
    __device__ __forceinline__ void operator()(const pg8::f32x4 (&acc)[2][2][4][2], const pg8::Unit& u, int wr, int wc, int fr, int fq) const {
        const int row0 = u.pm * 256 + wr * 64 + fr, col0 = u.pn * 256 + wc * 32 + 8 * fq;
        f32x4 b4[2][2];
#pragma unroll
        for (int bj = 0; bj < 2; ++bj) { b4[bj][0] = *(const f32x4*)(bglu + col0 + bj * 128); b4[bj][1] = *(const f32x4*)(bglu + col0 + bj * 128 + 4); }
#pragma unroll
        for (int ai = 0; ai < 2; ++ai)
#pragma unroll
            for (int m = 0; m < 4; ++m) { const size_t ro = (size_t)(row0 + ai * 128 + m * 16) * DM + col0;
#pragma unroll
                for (int bj = 0; bj < 2; ++bj) { const f32x4 t0 = acc[ai][bj][m][0] + b4[bj][0], t1 = acc[ai][bj][m][1] + b4[bj][1];
                    const v4u yv = *(const v4u*)(YG + ro + bj * 128), zv = *(const v4u*)(SZ1 + ro + bj * 128);
                    float o[8];
#pragma unroll
                    for (int j = 0; j < 8; ++j) { const unsigned yw = yv[j >> 1], zw = zv[j >> 1];
                        const float y = bf2f((unsigned short)((j & 1) ? (yw >> 16) : (yw & 0xffffu))), z = bf2f((unsigned short)((j & 1) ? (zw >> 16) : (zw & 0xffffu)));
                        const float t = j < 4 ? t0[j] : t1[j - 4];
                        o[j] = y * z / (1.0f + __expf(-t)); }
                    v4u w; w.x = pk2(o[0], o[1]); w.y = pk2(o[2], o[3]); w.z = pk2(o[4], o[5]); w.w = pk2(o[6], o[7]);
                    *(v4u*)(Y2 + ro + bj * 128) = w; } }
    }
};

__device__ __forceinline__ void final_norm_rows(Frame& F, float* X, const float* g) {
    const int gw = F.bid * NWAVES + F.wave, NGW = F.G * NWAVES;
    for (int m = gw; m < MT; m += NGW) {
        float* xr = X + (size_t)m * DM;
        f32x4 v[8]; float s = 0.f;
#pragma unroll
        for (int j = 0; j < 8; ++j) { v[j] = *(const f32x4*)(xr + 4 * F.lane + 256 * j); s += (v[j].x * v[j].x + v[j].y * v[j].y) + (v[j].z * v[j].z + v[j].w * v[j].w); }
        const float rstd = 1.0f / sqrtf(wave_sum(s) * (1.f / DM) + EPS);
#pragma unroll
        for (int j = 0; j < 8; ++j) { const int c = 4 * F.lane + 256 * j; const f32x4 gg = *(const f32x4*)(g + c);
            *(f32x4*)(xr + c) = (v[j] * rstd) * gg; }
    }
}

namespace att {
using f32x16 = __attribute__((ext_vector_type(16))) float;
using s16x4  = __attribute__((ext_vector_type(4))) short;
typedef short v4i16_t __attribute__((ext_vector_type(4)));
#define KSWZ(row, colB) ((row) * 256 + ((colB) ^ (((row) & 7) << 4)))
#define SBAR() __builtin_amdgcn_sched_barrier(0)
__device__ __forceinline__ int crow(int r, int hi) { return (r & 3) + 8 * (r >> 2) + 4 * hi; }
__device__ __forceinline__ int v_st(int k, int c) { const int kk = (k & ~0xC) | ((k & 4) << 1) | ((k & 8) >> 1); return ((kk >> 3) * 4 + (c >> 5)) * 512 + ((kk & 7) * 32 + (c & 31)) * 2; }
__device__ __forceinline__ int v_rd_base(int lane) { return ((lane & 3) << 3) | (((lane >> 2) & 3) << 6) | (((lane >> 4) & 1) << 5) | (((lane >> 5) & 1) << 8); }
constexpr int v_rd_off(int d0, int ks, int half) { return d0 * 512 + ks * 4096 + half * 2048; }
template <int OFF> __device__ __forceinline__ s16x4 tr_read(int vb) {
  s16x4 r; asm volatile("ds_read_b64_tr_b16 %0, %1 offset:%2" : "=&v"(r) : "v"(vb), "i"(OFF) : "memory"); return r;
}
__device__ __forceinline__ void qkt(f32x16& p0, f32x16& p1, const LAS unsigned char* Ks, const bf16x8* qr, int r32, int hi) {
  p0 = f32x16{}; p1 = f32x16{};
#pragma unroll
  for (int d0 = 0; d0 < 8; ++d0) { const int cb = (d0 * 16 + hi * 8) * 2;
    const bf16x8 b0 = *(const LAS bf16x8*)(Ks + KSWZ(r32, cb));
    const bf16x8 b1 = *(const LAS bf16x8*)(Ks + KSWZ(32 + r32, cb));
    p0 = __builtin_amdgcn_mfma_f32_32x32x16_bf16(b0, qr[d0], p0, 0, 0, 0);
    p1 = __builtin_amdgcn_mfma_f32_32x32x16_bf16(b1, qr[d0], p1, 0, 0, 0); }
}
template <int D0> __device__ __forceinline__ void pv_one(f32x16& od, int vb, bf16x8 pa0, bf16x8 pa1, bf16x8 pa2, bf16x8 pa3) {
  const s16x4 l0 = tr_read<v_rd_off(D0, 0, 0)>(vb), h0 = tr_read<v_rd_off(D0, 0, 1)>(vb), l1 = tr_read<v_rd_off(D0, 1, 0)>(vb), h1 = tr_read<v_rd_off(D0, 1, 1)>(vb);
  const s16x4 l2 = tr_read<v_rd_off(D0, 2, 0)>(vb), h2 = tr_read<v_rd_off(D0, 2, 1)>(vb), l3 = tr_read<v_rd_off(D0, 3, 0)>(vb), h3 = tr_read<v_rd_off(D0, 3, 1)>(vb);
  asm volatile("s_waitcnt lgkmcnt(0)" ::: "memory"); SBAR();
#define PK(L, H) (bf16x8){L[0], L[1], L[2], L[3], H[0], H[1], H[2], H[3]}
  od = __builtin_amdgcn_mfma_f32_32x32x16_bf16(pa0, PK(l0, h0), od, 0, 0, 0);
  od = __builtin_amdgcn_mfma_f32_32x32x16_bf16(pa1, PK(l1, h1), od, 0, 0, 0);
  od = __builtin_amdgcn_mfma_f32_32x32x16_bf16(pa2, PK(l2, h2), od, 0, 0, 0);
  od = __builtin_amdgcn_mfma_f32_32x32x16_bf16(pa3, PK(l3, h3), od, 0, 0, 0);
#undef PK
}
constexpr int L_K = 0, L_V = 16384, L_WS = 32768, L_RPB = 34816;

__device__ __forceinline__ void unit(Frame& F, int lat, int b, int h, int rq) {
  const int tid = F.tid, wid = F.wave, lane = F.lane, r32 = lane & 31, hi = lane >> 5;
  const bf16* QB = (const bf16*)(F.ws + WS_QB); const bf16* KB = (const bf16*)(F.ws + WS_KB); const bf16* VB = (const bf16*)(F.ws + WS_VB);
  const bf16* CK = (const bf16*)(F.ws + WS_CK); const bf16* CV = (const bf16*)(F.ws + WS_CV); const bf16* SZ = (const bf16*)(F.ws + WS_SZ);
  bf16* A2 = (bf16*)(F.ws + WS_ACTA);
  const LAS unsigned char* K_lds = F.lds + L_K; const LAS unsigned char* V_lds = F.lds + L_V;
  LAS float* wsf = (LAS float*)(F.lds + L_WS) + wid * 64; LAS float* rpb = (LAS float*)(F.lds + L_RPB);
  const int q0 = lat ? (MP + b * 1024 + rq * 256) : b * 256;
  const int hc = h * HD;
  int klo = 0, nloc = 0;
  if (lat) { const int r0a = min(max(4 * rq - 4, 0), 8), r0b = min(max(4 * rq + 3 - 4, 0), 8); klo = r0a; nloc = r0b + 8 - r0a; }
  const int ntiles = lat ? 8 + nloc : 4;
  const int R = 4 * rq + (wid >> 1), r0w = min(max(R - 4, 0), 8);
  const int qc = (wid & 1) * 32 + r32, c0 = min(max(qc - 8, 0), 48);
  __syncthreads();
  if (lat) { for (int i = tid; i < 15 * 31; i += NWAVES * 64) rpb[i] = F.in[11][h * 465 + i] * 1.4426950408889634f; }
  bf16x8 qr[8];
  { const bf16* Qw = QB + (size_t)(q0 + wid * 32 + r32) * DM + hc + hi * 8;
#pragma unroll
    for (int d0 = 0; d0 < 8; ++d0) qr[d0] = *(const bf16x8*)(Qw + d0 * 16); }
  const int sr = tid >> 4, sc = (tid & 15) * 8, vst0 = v_st(sr, sc), vst1 = v_st(32 + sr, sc);
  const int vb0 = (int)(uintptr_t)(F.lds + L_V) + v_rd_base(lane);
  float m_reg = -1e30f, l_reg = 0.f; f32x16 o[4] = {};
  for (int t = 0; t < ntiles; ++t) {
    const bf16 *Kt, *Vt; int kr = 0; bool local = false;
    if (!lat) { const size_t off = (size_t)(b * 256 + t * 64) * DM + hc; Kt = KB + off; Vt = VB + off; }
    else if (t < 8) { const size_t off = (size_t)(b * 512 + t * 64) * DM + hc; Kt = CK + off; Vt = CV + off; }
    else { kr = klo + (t - 8); local = true; const size_t off = (size_t)(MP + b * 1024 + kr * 64) * DM + hc; Kt = KB + off; Vt = VB + off; }
    const bf16x8 k0v = *(const bf16x8*)(Kt + (size_t)sr * DM + sc), k1v = *(const bf16x8*)(Kt + (size_t)(32 + sr) * DM + sc);
    const bf16x8 v0v = *(const bf16x8*)(Vt + (size_t)sr * DM + sc), v1v = *(const bf16x8*)(Vt + (size_t)(32 + sr) * DM + sc);
    __syncthreads();
    *(LAS bf16x8*)(F.lds + L_K + KSWZ(sr, sc * 2)) = k0v; *(LAS bf16x8*)(F.lds + L_K + KSWZ(32 + sr, sc * 2)) = k1v;
    *(LAS bf16x8*)(F.lds + L_V + vst0) = v0v; *(LAS bf16x8*)(F.lds + L_V + vst1) = v1v;
    __syncthreads();
    const bool active = !local || (kr >= r0w && kr < r0w + 8);
    if (active) {
      f32x16 p0, p1;
      qkt(p0, p1, K_lds, qr, r32, hi);
      if (local) {
        const int rb = (kr - R + 7) * 31 + 15 - qc;
#pragma unroll
        for (int r = 0; r < 16; ++r) { const int ka = crow(r, hi), kb2 = 32 + ka;
          p0[r] = (ka >= c0 && ka < c0 + 16) ? p0[r] + rpb[rb + ka] : -1e30f;
          p1[r] = (kb2 >= c0 && kb2 < c0 + 16) ? p1[r] + rpb[rb + kb2] : -1e30f; }
      }
      float pmax = p0[0];
#pragma unroll
      for (int r = 1; r < 16; ++r) pmax = fmaxf(pmax, p0[r]);
#pragma unroll
      for (int r = 0; r < 16; ++r) pmax = fmaxf(pmax, p1[r]);
      { auto rr = __builtin_amdgcn_permlane32_swap(__float_as_uint(pmax), __float_as_uint(pmax), false, false);
        pmax = fmaxf(__uint_as_float(rr[0]), __uint_as_float(rr[1])); }
      const float mn = fmaxf(m_reg, pmax); const float alpha = __builtin_amdgcn_exp2f(m_reg - mn); m_reg = mn;
      float ps = 0.f;
#pragma unroll
      for (int r = 0; r < 16; ++r) { p0[r] = __builtin_amdgcn_exp2f(p0[r] - mn); p1[r] = __builtin_amdgcn_exp2f(p1[r] - mn); ps += p0[r] + p1[r]; }
      { auto rr = __builtin_amdgcn_permlane32_swap(__float_as_uint(ps), __float_as_uint(ps), false, false);
        ps = __uint_as_float(rr[0]) + __uint_as_float(rr[1]); }
      l_reg = l_reg * alpha + ps;
      bf16x8 pa0, pa1, pa2, pa3;
#define PK4(P, BASE, OUT) do { unsigned a0 = pk2(P[BASE + 0], P[BASE + 1]), a1 = pk2(P[BASE + 2], P[BASE + 3]);   \
    unsigned b0 = pk2(P[BASE + 4], P[BASE + 5]), b1 = pk2(P[BASE + 6], P[BASE + 7]);                              \
    auto r0_ = __builtin_amdgcn_permlane32_swap(a0, b0, false, false); auto r1_ = __builtin_amdgcn_permlane32_swap(a1, b1, false, false); \
    v4u w_ = {r0_[0], r1_[0], r0_[1], r1_[1]}; OUT = __builtin_bit_cast(bf16x8, w_); } while (0)
      PK4(p0, 0, pa0); PK4(p0, 8, pa1); PK4(p1, 0, pa2); PK4(p1, 8, pa3);
#undef PK4
      if (hi == 0) wsf[r32] = alpha;
      asm volatile("s_waitcnt lgkmcnt(0)" ::: "memory");
#pragma unroll
      for (int r = 0; r < 16; ++r) { const float al = wsf[crow(r, hi)];
#pragma unroll
        for (int d = 0; d < 4; ++d) o[d][r] *= al; }
      pv_one<0>(o[0], vb0, pa0, pa1, pa2, pa3); pv_one<1>(o[1], vb0, pa0, pa1, pa2, pa3);
      pv_one<2>(o[2], vb0, pa0, pa1, pa2, pa3); pv_one<3>(o[3], vb0, pa0, pa1, pa2, pa3);
    }
  }
  asm volatile("s_waitcnt lgkmcnt(0)" ::: "memory");
  if (hi == 0) wsf[32 + r32] = l_reg;
  asm volatile("s_waitcnt lgkmcnt(0)" ::: "memory");
#pragma unroll
  for (int r = 0; r < 16; ++r) { const int orow = crow(r, hi); const float rl = __builtin_amdgcn_rcpf(wsf[32 + orow]);
    const size_t ro = (size_t)(q0 + wid * 32 + orow) * DM + hc + r32;
#pragma unroll
    for (int d0 = 0; d0 < 4; ++d0) { const float z = bf2f(SZ[ro + d0 * 32]); A2[ro + d0 * 32] = (bf16)f2bf(o[d0][r] * rl * z); } }
}

__device__ __forceinline__ void phase(Frame& F) {
  volatile LAS unsigned* MISC = (volatile LAS unsigned*)(F.lds + MISC_OFF);
  unsigned* q = (unsigned*)(F.ws + WS_CTL) + CW_QATT;
  constexpr int NLAT = 2 * NH * 4, NCTX = 32 * NH, NU = NLAT + NCTX;
  for (;;) {
    if (F.tid == 0) MISC[0] = __hip_atomic_fetch_add(q, 1u, RLX_AGENT);
    __syncthreads();
    const int u = (int)MISC[0];
    __syncthreads();
    if (u >= NU) break;
    if (u < NLAT) { const int rq = u & 3, h = (u >> 2) & 15, b = u >> 6; unit(F, 1, b, h, rq); }
    else { const int j = u - NLAT; unit(F, 0, j >> 4, j & 15, 0); }
  }
}
#undef KSWZ
#undef SBAR
}

namespace s5 {
using f32x16 = __attribute__((ext_vector_type(16))) float;
typedef short v4i16_t __attribute__((ext_vector_type(4)));
constexpr int IMG_ROW = 72;
constexpr int IMG_BYTES = 128 * IMG_ROW;

__device__ __forceinline__ void sincos_acc(float x, float& s, float& c) {
  const float k = rintf(x * 0.63661977236758134f);
  float r = fmaf(-k, 1.5707962512969971f, x); r = fmaf(-k, 7.5497894158615964e-08f, r); r = fmaf(-k, 5.3903029534742384e-15f, r);
  const float r2 = r * r;
  const float sp = r + r * r2 * (-1.6666654611e-1f + r2 * (8.3321608736e-3f + r2 * (-1.9515295891e-4f)));
  const float cp = 1.0f + r2 * (-0.5f + r2 * (4.166664568298827e-2f + r2 * (-1.388731625493765e-3f + r2 * 2.443315711809948e-5f)));
  const int q = ((int)k) & 3;
  const float ss = (q & 1) ? cp : sp, cc = (q & 1) ? sp : cp;
  s = (q & 2) ? -ss : ss; c = ((q + 1) & 2) ? -cc : cc;
}

__device__ __forceinline__ void precompute(Frame& F) {
  const int gw = F.bid * NWAVES + F.wave, NGW = F.G * NWAVES, lane = F.lane;
  bf16* SB = (bf16*)(F.ws + WS_S5B); bf16* SC = (bf16*)(F.ws + WS_S5C); float* SA = (float*)(F.ws + WS_S5A);
  for (int u = gw; u < 256; u += NGW) {
    const int d = u >> 7, g = u & 127, p = lane;
    const float dt = expf(F.in[19][d * 128 + g]);
    const float ar = F.in[17][(d * 128 + g) * 64 + p], ai = F.in[18][(d * 128 + g) * 64 + p];
    const float mag = expf(ar * dt); float sn, cs; sincos_acc(ai * dt, sn, cs);
    const float abr = mag * cs, abi = mag * sn;
    const float den = ar * ar + ai * ai, nr = abr - 1.0f;
    const float fre = (nr * ar + abi * ai) / den, fim = (abi * ar - nr * ai) / den;
    SA[((d * 128 + g) * 64 + p) * 2 + 0] = abr; SA[((d * 128 + g) * 64 + p) * 2 + 1] = abi;
    const float* bre = F.in[20] + ((size_t)(d * 128 + g) * 64 + p) * 16; const float* bim = F.in[21] + ((size_t)(d * 128 + g) * 64 + p) * 16;
    bf16* sb = SB + (size_t)(d * 128 + g) * 4 * 64 * 8;
#pragma unroll
    for (int c = 0; c < 16; ++c) { const float br = bre[c], bi = bim[c];
      const float vr = fre * br - fim * bi, vi = fre * bi + fim * br;
      const int l2 = (p & 31) + 32 * (c >> 3), j = c & 7, nb = 2 * (p >> 5);
      sb[((nb + 0) * 64 + l2) * 8 + j] = (bf16)f2bf(vr); sb[((nb + 1) * 64 + l2) * 8 + j] = (bf16)f2bf(vi); }
    const float* cre = F.in[22] + (size_t)(d * 128 + g) * 16 * 64; const float* cim = F.in[23] + (size_t)(d * 128 + g) * 16 * 64;
    bf16* scp = SC + (size_t)(d * 128 + g) * 4 * 64 * 8;
#pragma unroll
    for (int ks = 0; ks < 4; ++ks)
#pragma unroll
      for (int j = 0; j < 8; ++j) { const int c = lane & 15, pp = 32 * (ks >> 1) + 8 * (lane >> 4) + j;
        const float v = (ks & 1) ? -cim[c * 64 + pp] : cre[c * 64 + pp];
        scp[(ks * 64 + lane) * 8 + j] = (bf16)f2bf(v); }
  }
}

__device__ __forceinline__ float gelu_tanh(float v) {
  const float u = 0.7978845608028654f * (v + 0.044715f * v * v * v);
  const float e = __expf(2.0f * u);
  const float th = 1.0f - 2.0f / (e + 1.0f);
  return 0.5f * v * (1.0f + th);
}

__device__ __forceinline__ void unit(Frame& F, int lat, int pj, int gq) {
  const int wid = F.wave, lane = F.lane, half = lane >> 5, col = lane & 31;
  const int g = 4 * gq + (wid & 3), d = wid >> 2;
  const int L = lat ? 1024 : 256, NT = L / 16;
  const bf16* UB = (const bf16*)(F.ws + WS_KB);
  float* YP = (float*)(F.ws + WS_ACTA);
  bf16* YG = (bf16*)(F.ws + WS_SZ);
  const LAS unsigned char* img = F.lds + wid * IMG_BYTES;
  const int rbase0 = lat ? MP : (2 * pj) * 256, rbase1 = lat ? MP + 1024 : (2 * pj + 1) * 256;
  bf16x8 Bf[4], Cf[4];
  { const bf16* sb = (const bf16*)(F.ws + WS_S5B) + (size_t)(d * 128 + g) * 4 * 64 * 8; const bf16* sc = (const bf16*)(F.ws + WS_S5C) + (size_t)(d * 128 + g) * 4 * 64 * 8;
#pragma unroll
    for (int i = 0; i < 4; ++i) { Bf[i] = *(const bf16x8*)(sb + (i * 64 + lane) * 8); Cf[i] = *(const bf16x8*)(sc + (i * 64 + lane) * 8); } }
  const float* SA = (const float*)(F.ws + WS_S5A) + (size_t)(d * 128 + g) * 64 * 2;
  const float a0r = SA[col * 2], a0i = SA[col * 2 + 1], a1r = SA[(32 + col) * 2], a1i = SA[(32 + col) * 2 + 1];
  float h0r = 0.f, h0i = 0.f, h1r = 0.f, h1i = 0.f;
  if (lat) { const float* st = F.in[4] + (size_t)((half * 2 + d) * 2) * 128 * 64 + (size_t)g * 64;
    h0r = st[col]; h1r = st[32 + col]; h0i = st[128 * 64 + col]; h1i = st[128 * 64 + 32 + col]; }
  const int sA = (col >> 2) & 1, rA = (col & 3) + 4 * (col >> 3);
  const bf16* ubase = UB + (size_t)(sA ? rbase1 : rbase0) * DM + g * 16 + 8 * half;
  const int tA0 = d ? (L - 1 - rA) : rA, tstep = d ? -16 : 16;
  const int tk = lane & 15, c0 = 4 * (lane >> 4);
  const int tR0 = d ? (L - 1 - tk) : tk;
  const f32x4 dsk = *(const f32x4*)(F.in[24] + g * 16 + c0);
  bf16x8 ucur = *(const bf16x8*)(ubase + (size_t)tA0 * DM);
  for (int i = 0; i < NT; ++i) {
    bf16x8 unext = ucur;
    if (i + 1 < NT) unext = *(const bf16x8*)(ubase + (size_t)(tA0 + (i + 1) * tstep) * DM);
    if (i == NT / 2) { asm volatile("s_waitcnt vmcnt(0)" ::: "memory"); __syncthreads(); }
    f32x16 X0 = __builtin_amdgcn_mfma_f32_32x32x16_bf16(ucur, Bf[0], f32x16{}, 0, 0, 0);
    f32x16 X1 = __builtin_amdgcn_mfma_f32_32x32x16_bf16(ucur, Bf[1], f32x16{}, 0, 0, 0);
    f32x16 X2 = __builtin_amdgcn_mfma_f32_32x32x16_bf16(ucur, Bf[2], f32x16{}, 0, 0, 0);
    f32x16 X3 = __builtin_amdgcn_mfma_f32_32x32x16_bf16(ucur, Bf[3], f32x16{}, 0, 0, 0);
#pragma unroll
    for (int r = 0; r < 16; ++r) {
      const float n0r = fmaf(a0r, h0r, fmaf(-a0i, h0i, X0[r])), n0i = fmaf(a0r, h0i, fmaf(a0i, h0r, X1[r]));
      const float n1r = fmaf(a1r, h1r, fmaf(-a1i, h1i, X2[r])), n1i = fmaf(a1r, h1i, fmaf(a1i, h1r, X3[r]));
      h0r = n0r; h0i = n0i; h1r = n1r; h1i = n1i; X0[r] = n0r; X1[r] = n0i; X2[r] = n1r; X3[r] = n1i;
    }
    { const LAS unsigned char* wp = img + col * IMG_ROW + half * 32;
#pragma unroll
      for (int q = 0; q < 4; ++q) {
        v2u w0, w1, w2, w3;
        w0.x = pk2(X0[4 * q], X0[4 * q + 1]); w0.y = pk2(X0[4 * q + 2], X0[4 * q + 3]);
        w1.x = pk2(X1[4 * q], X1[4 * q + 1]); w1.y = pk2(X1[4 * q + 2], X1[4 * q + 3]);
        w2.x = pk2(X2[4 * q], X2[4 * q + 1]); w2.y = pk2(X2[4 * q + 2], X2[4 * q + 3]);
        w3.x = pk2(X3[4 * q], X3[4 * q + 1]); w3.y = pk2(X3[4 * q + 2], X3[4 * q + 3]);
        *(LAS v2u*)(wp + 0 * 32 * IMG_ROW + q * 8) = w0; *(LAS v2u*)(wp + 1 * 32 * IMG_ROW + q * 8) = w1;
        *(LAS v2u*)(wp + 2 * 32 * IMG_ROW + q * 8) = w2; *(LAS v2u*)(wp + 3 * 32 * IMG_ROW + q * 8) = w3; } }
    asm volatile("s_waitcnt lgkmcnt(0)" ::: "memory");
    f32x4 yv[2];
#pragma unroll
    for (int hs = 0; hs < 2; ++hs) {
      f32x4 acc = {0.f, 0.f, 0.f, 0.f};
      const LAS unsigned char* rp = img + (8 * (lane >> 4) + ((lane >> 2) & 3)) * IMG_ROW + hs * 32 + (lane & 3) * 8;
#pragma unroll
      for (int ks = 0; ks < 4; ++ks) {
        const v4i16_t lo = __builtin_amdgcn_ds_read_tr16_b64_v4i16((LAS v4i16_t*)(rp + (32 * ks) * IMG_ROW));
        const v4i16_t hi4 = __builtin_amdgcn_ds_read_tr16_b64_v4i16((LAS v4i16_t*)(rp + (32 * ks + 4) * IMG_ROW));
        const bf16x8 bfr = (bf16x8){lo[0], lo[1], lo[2], lo[3], hi4[0], hi4[1], hi4[2], hi4[3]};
        acc = __builtin_amdgcn_mfma_f32_16x16x32_bf16(Cf[ks], bfr, acc, 0, 0, 0);
      }
      yv[hs] = acc;
    }
    const int t = tR0 + i * tstep;
#pragma unroll
    for (int hs = 0; hs < 2; ++hs) {
      const size_t off = (size_t)((hs ? rbase1 : rbase0) + t) * DM + g * 16 + c0;
      if (i < NT / 2) { *(f32x4*)(YP + off) = yv[hs]; }
      else {
        const f32x4 other = __builtin_nontemporal_load((const f32x4*)(YP + off));
        const v2u uu = *(const v2u*)(UB + off);
        f32x4 y = yv[hs] + other;
        y.x += dsk.x * bf2f((unsigned short)(uu.x & 0xffffu)); y.y += dsk.y * bf2f((unsigned short)(uu.x >> 16));
        y.z += dsk.z * bf2f((unsigned short)(uu.y & 0xffffu)); y.w += dsk.w * bf2f((unsigned short)(uu.y >> 16));
        v2u w; w.x = pk2(gelu_tanh(y.x), gelu_tanh(y.y)); w.y = pk2(gelu_tanh(y.z), gelu_tanh(y.w));
        *(v2u*)(YG + off) = w;
      }
    }
    ucur = unext;
  }
  if (!lat) { float* ns = F.out + OUT_ST + (size_t)(((2 * pj + half) * 2 + d) * 2) * 128 * 64 + (size_t)g * 64;
    ns[col] = h0r; ns[32 + col] = h1r; ns[128 * 64 + col] = h0i; ns[128 * 64 + 32 + col] = h1i; }
}

__device__ __forceinline__ void phase(Frame& F) {
  volatile LAS unsigned* MISC = (volatile LAS unsigned*)(F.lds + MISC_OFF);
  unsigned* q = (unsigned*)(F.ws + WS_CTL) + CW_QS5;
  constexpr int NLAT = 32, NPR = 16 * 32, NU = NLAT + NPR;
  for (;;) {
    if (F.tid == 0) MISC[0] = __hip_atomic_fetch_add(q, 1u, RLX_AGENT);
    __syncthreads();
    const int u = (int)MISC[0];
    __syncthreads();
    if (u >= NU) break;
    if (u < NLAT) unit(F, 1, 0, u);
    else { const int j = u - NLAT; unit(F, 0, j >> 5, j & 31); }
  }
}
}

__device__ __forceinline__ void s5_precompute_hook(Frame& F) { s5::precompute(F); }
__global__ void __launch_bounds__(NWAVES * 64, 2) mk_fwd(Args args) {
    extern __shared__ __attribute__((aligned(16))) unsigned char lds_raw[];
    Frame F;
    F.lds = (LAS unsigned char*)lds_raw;
    F.tid = threadIdx.x; F.lane = F.tid & 63; F.wave = __builtin_amdgcn_readfirstlane(F.tid >> 6);
    F.bid = blockIdx.x; F.G = gridDim.x;
    F.in = args.in; F.out = args.out; F.ws = args.ws;
    volatile LAS unsigned* MISC = (volatile LAS unsigned*)(F.lds + MISC_OFF);
    for (int u = F.tid; u < (LDS_BYTES - RING_BYTES) / 4; u += NWAVES * 64) ((LAS unsigned*)(F.lds + RING_BYTES))[u] = 0u;
    __syncthreads();
    const int lo = args.ph_lo, hi = args.ph_hi;
    const bool one = (hi - lo) > 1;
    XcdBarrier bar; bar.bar = (unsigned*)(F.ws + WS_CTL) + CW_BAR; bar.x = 0; bar.st = nullptr;
    if (one) bar = xcd_barrier_post((unsigned*)(F.ws + WS_CTL) + CW_BAR, MISC + 8);
#define IN(k) (lo <= (k) && (k) < hi)
#define SEAM(k) do { if (IN(k) && IN((k) + 1)) xcd_barrier(bar); } while (0)
    float* ADA = (float*)(F.ws + WS_ADA);

    if (IN(0)) { p0_prologue(F); SEAM(0); }
    if (IN(1)) { norm_mod_rows<true>(F, nullptr, F.in[7], ADA, (bf16*)(F.ws + WS_ACTA)); SEAM(1); }
    if (IN(2)) {
        pg8::Gemm g{(const bf16*)(F.ws + WS_ACTA), (const bf16*)(F.ws + WS_W1), MT, 8192, DM}; pg8::StaticOrder S; S.init(MT, 8192, F.G, F.bid);
        EpiL0In E{(bf16*)(F.ws + WS_QB), (bf16*)(F.ws + WS_KB), (bf16*)(F.ws + WS_VB), (bf16*)(F.ws + WS_SZ), F.out + OUT_NK, F.out + OUT_NV, 0.088388347648318440f * 1.4426950408889634f};
        pg8::gemm_phase<EpiL0In, pg8::StaticOrder, true, true>(F.lds, g, S, E);
        SEAM(2);
    }
    if (IN(3)) { att::phase(F); SEAM(3); }
    float* XRES = F.out + OUT_Y;
    if (IN(4)) {
        pg8::Gemm g{(const bf16*)(F.ws + WS_ACTA), (const bf16*)(F.ws + WS_W2), MT, DM, DM}; pg8::StaticOrder S; S.init(MT, DM, F.G, F.bid);
        EpiResid<true> E{F.in[0], F.in[1], XRES, ADA};
        pg8::gemm_phase<EpiResid<true>, pg8::StaticOrder, true, true>(F.lds, g, S, E);
        SEAM(4);
    }
    if (IN(5)) { norm_mod_rows<false>(F, XRES, F.in[13], ADA + 3 * 6144, (bf16*)(F.ws + WS_QB)); SEAM(5); }
    if (IN(6)) {
        pg8::Gemm g{(const bf16*)(F.ws + WS_QB), (const bf16*)(F.ws + WS_W3), MT, 4096, DM}; pg8::StaticOrder S; S.init(MT, 4096, F.G, F.bid);
        EpiL1In E{(bf16*)(F.ws + WS_KB), (bf16*)(F.ws + WS_VB)};
        pg8::gemm_phase<EpiL1In, pg8::StaticOrder, true, true>(F.lds, g, S, E);
        SEAM(6);
    }
    if (IN(7)) { s5::phase(F); SEAM(7); }
    if (IN(8)) {
        pg8::Gemm g{(const bf16*)(F.ws + WS_SZ), (const bf16*)(F.ws + WS_W4), MT, DM, DM}; pg8::StaticOrder S; S.init(MT, DM, F.G, F.bid);
        EpiGlu E{(const bf16*)(F.ws + WS_SZ), (const bf16*)(F.ws + WS_VB), F.in[26], (bf16*)(F.ws + WS_ACTA)};
        pg8::gemm_phase<EpiGlu, pg8::StaticOrder, true, true>(F.lds, g, S, E);
        SEAM(8);
    }
    if (IN(9)) {
        pg8::Gemm g{(const bf16*)(F.ws + WS_ACTA), (const bf16*)(F.ws + WS_W5), MT, DM, DM}; pg8::StaticOrder S; S.init(MT, DM, F.G, F.bid);
        EpiResid<false> E{nullptr, nullptr, XRES, ADA + 3 * 6144};
        pg8::gemm_phase<EpiResid<false>, pg8::StaticOrder, true, true>(F.lds, g, S, E);
        SEAM(9);
    }
    if (IN(10)) { final_norm_rows(F, XRES, F.in[28]); }
#undef IN
#undef SEAM
}

extern "C" void kernel_launch(void* const* d_in, const int* in_sizes, int n_in, void* d_out, int out_size, void* d_ws, size_t ws_size, hipStream_t stream) {
    static int grid = 0;
    if (grid == 0) {
        if (n_in != N_IN || ws_size < WS_END) { fprintf(stderr, "kernel_launch: unexpected n_in %d or ws_size %zu (need %zu)\n", n_in, ws_size, (size_t)WS_END); grid = -1; return; }
        int dev = 0, cus = 0;
        if (hipGetDevice(&dev) != hipSuccess || hipDeviceGetAttribute(&cus, hipDeviceAttributeMultiprocessorCount, dev) != hipSuccess) { grid = -1; return; }
        if (hipFuncSetAttribute((const void*)mk_fwd, hipFuncAttributeMaxDynamicSharedMemorySize, LDS_BYTES) != hipSuccess) { fprintf(stderr, "kernel_launch: hipFuncSetAttribute failed\n"); grid = -1; return; }
        (void)hipGetLastError();
        grid = cus;
    }
    if (grid < 0) return;
    (void)hipMemsetAsync((char*)d_ws + WS_CTL, 0, CTL_ZERO_BYTES, stream);
    Args a{};
    for (int i = 0; i < N_IN; ++i) a.in[i] = (const float*)d_in[i];
    a.out = (float*)d_out; a.ws = (unsigned char*)d_ws;
#if MK_ONE_LAUNCH
    a.ph_lo = 0; a.ph_hi = NPHASE;
    hipLaunchKernelGGL(mk_fwd, dim3(grid), dim3(NWAVES * 64), LDS_BYTES, stream, a);
#else
    for (int p = 0; p < NPHASE; ++p) { a.ph_lo = p; a.ph_hi = p + 1; hipLaunchKernelGGL(mk_fwd, dim3(grid), dim3(NWAVES * 64), LDS_BYTES, stream, a); }
#endif
}
```

```cpp
#include <hip/hip_runtime.h>
#include <hip/hip_cooperative_groups.h>
#include <cstdio>
#include <cstdint>

#ifndef MK_ONE_LAUNCH
#define MK_ONE_LAUNCH 1
#endif
#ifndef XB_WG_RELEASE
#define XB_WG_RELEASE 0
#endif
#ifndef MK_COOP
#define MK_COOP 0
#endif
#ifndef PROBE_REP
#define PROBE_REP (-1)
#endif

namespace pg8 {
#define PG8_LAS __attribute__((address_space(3)))
typedef unsigned short bf16_t;
typedef short bf16x8 __attribute__((ext_vector_type(8)));
typedef float f32x4 __attribute__((ext_vector_type(4)));
typedef unsigned u32x4 __attribute__((ext_vector_type(4)));
constexpr int BM = 256, BK = 64, HALF = 128, HTB = HALF * BK * 2, STAGE_BYTES = 8 * HTB, NXCD = 8, WGM = 8;

__host__ __device__ __forceinline__ int lds_byte(int r, int c) { const int st = (r >> 4) * 2 + (c >> 5), rr = r & 15, cc = c & 31, ob = rr * 64 + cc * 2; return st * 1024 + (ob ^ (((ob >> 9) & 1) << 5)); }
__host__ __device__ __forceinline__ void stage_rc(int b, int& R, int& C) { const int st = b / 1024, sb = b % 1024, swz = sb ^ (((sb >> 9) & 1) << 5); R = (st >> 1) * 16 + swz / 64; C = (st & 1) * 32 + (swz % 64) / 2; }
__host__ __device__ __forceinline__ int perm32(int rho) { const int n = rho >> 4, i = rho & 15; return 8 * (i >> 2) + 4 * n + (i & 3); }

struct Unit { int pm, pn; };
struct Gemm { const bf16_t* A; const bf16_t* Bt; int M, N, K; };

struct StaticOrder {
    int nM, nN, nwg, G, c;
    __host__ __device__ void init(int M, int N, int G_, int c_) { nM = M / BM; nN = N / BM; nwg = nM * nN; G = G_; c = c_; }
    __host__ __device__ bool next(int i, Unit& u) const {
        const long L = (long)i * G + c; if (L >= nwg) return false;
        int wgid = (int)L; { const int q = nwg / NXCD, r = nwg % NXCD, xcd = wgid % NXCD, off = wgid / NXCD; wgid = (xcd < r ? xcd * (q + 1) : r * (q + 1) + (xcd - r) * q) + off; }
        const int nig = WGM * nN, gid = wgid / nig, fm = gid * WGM, gsz = (nM - fm) < WGM ? (nM - fm) : WGM;
        u.pm = fm + ((wgid % nig) % gsz); u.pn = (wgid % nig) / gsz; return true;
    }
    __device__ __forceinline__ void a_ready(const Unit&) const {}
    __device__ __forceinline__ void done(const Unit&) const {}
};

__device__ __forceinline__ unsigned cvt_pk_bf16(float lo, float hi) { unsigned r; asm volatile("v_cvt_pk_bf16_f32 %0, %1, %2" : "=v"(r) : "v"(lo), "v"(hi)); return r; }

template <class Epi, class Sched, bool ALIGN_EPI = false, bool SP2 = false>
__device__ __forceinline__ void gemm_phase(PG8_LAS unsigned char* lds, const Gemm g, const Sched& S, const Epi& E) {
    const int tid = threadIdx.x, wid = __builtin_amdgcn_readfirstlane(tid >> 6), lane = tid & 63, wr = wid >> 2, wc = wid & 3, fr = lane & 15, fq = lane >> 4;
    const int K = g.K, nt = K / BK;
    unsigned voffA[2], voffB[2];
#pragma unroll
    for (int i = 0; i < 2; ++i) { int R, C; stage_rc(tid * 16 + i * 8192, R, C); const int Rb = Epi::PERM ? ((R & ~31) + perm32(R & 31)) : R;
        voffA[i] = (unsigned)(R * K + C) * 2u; voffB[i] = (unsigned)(Rb * K + C) * 2u; }
    const size_t kstep = (size_t)(BK * 2);
    const size_t hstep = (size_t)HALF * K * 2;
    const size_t tstep = 2 * hstep;
    const unsigned ldsw = (unsigned)wid * 1024u;
    const int aoff = lds_byte(wr * 64 + fr, fq * 8), boff = lds_byte(wc * 32 + fr, fq * 8);
#define PG8_SA(b, h) (((b) * 2 + (h)) * HTB)
#define PG8_SB(b, h) ((4 + (b) * 2 + (h)) * HTB)
#define PG8_STAGE(bufoff, gbase, voff) do { _Pragma("unroll") for (int _i = 0; _i < 2; ++_i) \
        __builtin_amdgcn_global_load_lds((const unsigned*)((const char*)(gbase) + (voff)[_i]), (PG8_LAS unsigned*)(lds + (bufoff) + ldsw + _i * 8192), 16, 0, 0); } while (0)
#define PG8_LDA(dst, b, h) do { _Pragma("unroll") for (int m = 0; m < 4; ++m) _Pragma("unroll") for (int k = 0; k < 2; ++k) dst[m][k] = *(const PG8_LAS bf16x8*)(lds + PG8_SA(b, h) + aoff + m * 2048 + k * 1024); } while (0)
#define PG8_LDB(dst, b, h) do { _Pragma("unroll") for (int n = 0; n < 2; ++n) _Pragma("unroll") for (int k = 0; k < 2; ++k) dst[n][k] = *(const PG8_LAS bf16x8*)(lds + PG8_SB(b, h) + boff + n * 2048 + k * 1024); } while (0)
#define PG8_MMA(ai, bj, At, Bt) do { __builtin_amdgcn_s_setprio(1); _Pragma("unroll") for (int m = 0; m < 4; ++m) _Pragma("unroll") for (int n = 0; n < 2; ++n) _Pragma("unroll") for (int k = 0; k < 2; ++k) \
        acc[ai][bj][m][n] = __builtin_amdgcn_mfma_f32_16x16x32_bf16(Bt[n][k], At[m][k], acc[ai][bj][m][n], 0, 0, 0); __builtin_amdgcn_s_setprio(0); } while (0)
#define PG8_WAIT_V(n) asm volatile("s_waitcnt vmcnt(" #n ")" ::: "memory")
#define PG8_WAIT_L(n) asm volatile("s_waitcnt lgkmcnt(" #n ")" ::: "memory")
#define PG8_BAR __builtin_amdgcn_s_barrier()
#define PG8_SCHED __builtin_amdgcn_sched_barrier(0)
    Unit cur, nxt; int ui = 0;
    if (!S.next(0, cur)) return;
    f32x4 acc[2][2][4][2];
#pragma unroll
    for (int a = 0; a < 2; ++a)
#pragma unroll
        for (int b = 0; b < 2; ++b)
#pragma unroll
            for (int m = 0; m < 4; ++m)
#pragma unroll
                for (int n = 0; n < 2; ++n) acc[a][b][m][n] = (f32x4){0.f, 0.f, 0.f, 0.f};
    bf16x8 At[4][2], B0[2][2], B1[2][2];
    const char* cA = (const char*)g.A + (size_t)cur.pm * tstep; const char* cB = (const char*)g.Bt + (size_t)cur.pn * tstep;
    S.a_ready(cur);
    if constexpr (SP2) {
        PG8_STAGE(PG8_SB(0, 0), cB, voffB); PG8_STAGE(PG8_SB(0, 1), cB + hstep, voffB); PG8_STAGE(PG8_SA(0, 0), cA, voffA); PG8_STAGE(PG8_SA(0, 1), cA + hstep, voffA);
        if (wr == 1) PG8_BAR;
        PG8_WAIT_V(2); PG8_BAR;
        PG8_STAGE(PG8_SB(1, 0), cB + kstep, voffB); PG8_STAGE(PG8_SA(1, 0), cA + kstep, voffA); PG8_STAGE(PG8_SB(1, 1), cB + hstep + kstep, voffB);
        PG8_WAIT_V(6); PG8_BAR;
    } else {
        PG8_STAGE(PG8_SB(0, 0), cB, voffB); PG8_STAGE(PG8_SA(0, 0), cA, voffA); PG8_STAGE(PG8_SB(0, 1), cB + hstep, voffB); PG8_STAGE(PG8_SA(0, 1), cA + hstep, voffA);
        if (wr == 1) PG8_BAR;
        PG8_WAIT_V(4); PG8_BAR;
        PG8_STAGE(PG8_SB(1, 0), cB + kstep, voffB); PG8_STAGE(PG8_SA(1, 0), cA + kstep, voffA); PG8_STAGE(PG8_SB(1, 1), cB + hstep + kstep, voffB);
        PG8_WAIT_V(6); PG8_BAR;
    }
    for (;;) {
        const bool has_next = S.next(ui + 1, nxt);
        const char* nA = has_next ? (const char*)g.A + (size_t)nxt.pm * tstep : cA; const char* nB = has_next ? (const char*)g.Bt + (size_t)nxt.pn * tstep : cB;
        for (int t = 0; t < nt; t += 2) {
            const bool last = (t == nt - 2);
            const char* a1 = cA + (size_t)(t + 1) * kstep;
            const char* a2 = last ? nA : cA + (size_t)(t + 2) * kstep; const char* b2 = last ? nB : cB + (size_t)(t + 2) * kstep;
            const char* a3 = a2 + kstep; const char* b3 = b2 + kstep;
            if (last && has_next) S.a_ready(nxt);
            if constexpr (SP2) {
            PG8_LDB(B0, 0, 0); PG8_LDB(B1, 0, 1); PG8_SCHED; PG8_LDA(At, 0, 0); PG8_STAGE(PG8_SA(1, 1), a1 + hstep, voffA);
            PG8_WAIT_V(8); PG8_WAIT_L(0); PG8_BAR; PG8_MMA(0, 0, At, B0); PG8_MMA(0, 1, At, B1); PG8_BAR; PG8_SCHED;
            PG8_LDA(At, 0, 1); PG8_STAGE(PG8_SB(0, 0), b2, voffB); PG8_STAGE(PG8_SB(0, 1), b2 + hstep, voffB); PG8_STAGE(PG8_SA(0, 0), a2, voffA);
            PG8_WAIT_V(8); PG8_WAIT_L(0); PG8_BAR; PG8_MMA(1, 0, At, B0); PG8_MMA(1, 1, At, B1); PG8_BAR; PG8_SCHED;
            PG8_LDB(B0, 1, 0); PG8_LDB(B1, 1, 1); PG8_SCHED; PG8_LDA(At, 1, 0); PG8_STAGE(PG8_SA(0, 1), a2 + hstep, voffA);
            PG8_WAIT_V(8); PG8_WAIT_L(0); PG8_BAR; PG8_MMA(0, 0, At, B0); PG8_MMA(0, 1, At, B1); PG8_BAR; PG8_SCHED;
            PG8_LDA(At, 1, 1); PG8_STAGE(PG8_SB(1, 0), b3, voffB); PG8_STAGE(PG8_SB(1, 1), b3 + hstep, voffB); PG8_STAGE(PG8_SA(1, 0), a3, voffA);
            PG8_WAIT_V(8); PG8_WAIT_L(0); PG8_BAR; PG8_MMA(1, 0, At, B0); PG8_MMA(1, 1, At, B1); PG8_BAR; PG8_SCHED;
            } else {
            PG8_LDB(B0, 0, 0); PG8_SCHED; PG8_LDA(At, 0, 0); PG8_STAGE(PG8_SA(1, 1), a1 + hstep, voffA);
            PG8_WAIT_L(8); PG8_BAR; PG8_WAIT_L(0); PG8_MMA(0, 0, At, B0); PG8_BAR; PG8_SCHED;
            PG8_LDB(B1, 0, 1); PG8_STAGE(PG8_SB(0, 0), b2, voffB);
            PG8_BAR; PG8_WAIT_L(0); PG8_MMA(0, 1, At, B1); PG8_BAR;
            PG8_LDA(At, 0, 1); PG8_STAGE(PG8_SA(0, 0), a2, voffA);
            PG8_BAR; PG8_WAIT_L(0); PG8_MMA(1, 0, At, B0); PG8_BAR; PG8_SCHED;
            PG8_STAGE(PG8_SB(0, 1), b2 + hstep, voffB);
            PG8_WAIT_V(6); PG8_BAR; PG8_MMA(1, 1, At, B1); PG8_BAR;
            PG8_LDB(B0, 1, 0); PG8_SCHED; PG8_LDA(At, 1, 0); PG8_STAGE(PG8_SA(0, 1), a2 + hstep, voffA);
            PG8_WAIT_L(8); PG8_BAR; PG8_WAIT_L(0); PG8_MMA(0, 0, At, B0); PG8_BAR; PG8_SCHED;
            PG8_LDB(B1, 1, 1); PG8_STAGE(PG8_SB(1, 0), b3, voffB);
            PG8_BAR; PG8_WAIT_L(0); PG8_MMA(0, 1, At, B1); PG8_BAR;
            PG8_LDA(At, 1, 1); PG8_STAGE(PG8_SA(1, 0), a3, voffA);
            PG8_BAR; PG8_WAIT_L(0); PG8_MMA(1, 0, At, B0); PG8_BAR; PG8_SCHED;
            PG8_STAGE(PG8_SB(1, 1), b3 + hstep, voffB);
            PG8_WAIT_V(6); PG8_BAR; PG8_MMA(1, 1, At, B1); PG8_BAR;
            }
        }
        if constexpr (ALIGN_EPI) { if (wr == 0) PG8_BAR; }
        E(acc, cur, wr, wc, fr, fq); S.done(cur);
        if (!has_next) break;
#pragma unroll
        for (int a = 0; a < 2; ++a)
#pragma unroll
            for (int b = 0; b < 2; ++b)
#pragma unroll
                for (int m = 0; m < 4; ++m)
#pragma unroll
                    for (int n = 0; n < 2; ++n) acc[a][b][m][n] = (f32x4){0.f, 0.f, 0.f, 0.f};
        cur = nxt; cA = nA; cB = nB; ++ui;
        if constexpr (ALIGN_EPI) { if (wr == 1) PG8_BAR; }
    }
    PG8_WAIT_V(0);
    if constexpr (!ALIGN_EPI) { if (wr == 0) PG8_BAR; }
    PG8_BAR;
#undef PG8_SA
#undef PG8_SB
#undef PG8_STAGE
#undef PG8_LDA
#undef PG8_LDB
#undef PG8_MMA
#undef PG8_WAIT_V
#undef PG8_WAIT_L
#undef PG8_BAR
#undef PG8_SCHED
}
}

constexpr int NWAVES = 8;
constexpr int DM = 2048;
constexpr int MP = 8192, MS = 2048, MT = MP + MS;
constexpr int NH = 16, HD = 128;
constexpr float EPS = 1e-6f;
constexpr int N_IN = 29;
constexpr int NPHASE = 12;

constexpr size_t OUT_Y = 0, OUT_NK = (size_t)MT * DM, OUT_NV = OUT_NK + (size_t)MP * DM, OUT_ST = OUT_NV + (size_t)MP * DM;

constexpr size_t MiB = 1u << 20;
constexpr size_t WS_CTL = 0, CTL_ZERO_BYTES = 1 * MiB;
constexpr size_t WS_ADA = 1 * MiB;
constexpr size_t WS_W1 = 2 * MiB;
constexpr size_t WS_W2 = WS_W1 + 32 * MiB;
constexpr size_t WS_W3 = WS_W2 + 8 * MiB;
constexpr size_t WS_W4 = WS_W3 + 16 * MiB;
constexpr size_t WS_W5 = WS_W4 + 8 * MiB;
constexpr size_t WS_CK = WS_W5 + 8 * MiB;
constexpr size_t WS_CV = WS_CK + 4 * MiB;
constexpr size_t WS_S5B = WS_CV + 4 * MiB;
constexpr size_t WS_S5C = WS_S5B + 1 * MiB;
constexpr size_t WS_S5A = WS_S5C + 1 * MiB;
constexpr size_t WS_S5L = WS_S5A + 1 * MiB;
constexpr size_t WS_ACTA = WS_S5L + 1 * MiB;
constexpr size_t ACT_BYTES = (size_t)MT * DM * 2;
constexpr size_t WS_QB = WS_ACTA + ACT_BYTES;
constexpr size_t WS_KB = WS_QB + ACT_BYTES;
constexpr size_t WS_VB = WS_KB + ACT_BYTES;
constexpr size_t WS_SZ = WS_VB + ACT_BYTES;
constexpr size_t WS_END = WS_SZ + ACT_BYTES;
constexpr int CW_QUEUE = 64;
constexpr int CW_QATT = 128, CW_QS5 = 192;
constexpr int CW_BAR = 4096;

constexpr int RING_BYTES = 131072;
constexpr int MISC_OFF = RING_BYTES + 320;
constexpr int LDS_BYTES = 147456;

#define GAS __attribute__((address_space(1)))
#define LAS __attribute__((address_space(3)))
typedef unsigned short bf16;
typedef unsigned v4u __attribute__((ext_vector_type(4)));
typedef unsigned v2u __attribute__((ext_vector_type(2)));
typedef float f32x4 __attribute__((ext_vector_type(4)));
typedef short bf16x8 __attribute__((ext_vector_type(8)));
typedef GAS unsigned gu32;
#define RLX_AGENT __ATOMIC_RELAXED, __HIP_MEMORY_SCOPE_AGENT
#define LDS_WAIT() asm volatile("s_waitcnt lgkmcnt(0)" ::: "memory")
#define VM_WAIT() asm volatile("s_waitcnt vmcnt(0)" ::: "memory")
__device__ __forceinline__ unsigned f2bf(float f) { unsigned u = __builtin_bit_cast(unsigned, f); return (u + 0x7fffu + ((u >> 16) & 1u)) >> 16; }
__device__ __forceinline__ unsigned pk2(float lo, float hi) { return pg8::cvt_pk_bf16(lo, hi); }
__device__ __forceinline__ float bf2f(unsigned short b) { return __builtin_bit_cast(float, (unsigned)b << 16); }
__device__ __forceinline__ float siluf(float v) { return v / (1.f + __expf(-v)); }

#define XB_TMO      128
#define XB_XCNT(j)  (256  + 64 * (j))
#define XB_XSUB(j)  (1280 + 64 * (j))
#define XB_XGEN(j)  (2304 + 64 * (j))
#define XB_TOP      3328
#define XB_TOPGEN   3392
#define XCD_BAR_WORDS 3456
#define XB_SPIN_CAP (1u << 18)
__device__ __forceinline__ unsigned xb_ld(unsigned* p)              { return __hip_atomic_load(p, __ATOMIC_RELAXED, __HIP_MEMORY_SCOPE_AGENT); }
__device__ __forceinline__ unsigned xb_add(unsigned* p, unsigned v) { return __hip_atomic_fetch_add(p, v, __ATOMIC_RELAXED, __HIP_MEMORY_SCOPE_AGENT); }
__device__ __forceinline__ unsigned xb_xcc_id() { return (unsigned)__builtin_amdgcn_s_getreg((3 << 11) | 20) & 0xFu; }
#define XB_SPIN(cond, bar) do { unsigned _sp = 0; while (cond) { __builtin_amdgcn_s_sleep(1); \
    if ((++_sp & 255u) == 0u) { if (xb_ld(&(bar)[XB_TMO])) break; if (_sp > XB_SPIN_CAP) { atomicAdd(&(bar)[XB_TMO], 1u); break; } } } } while (0)
struct XcdBarrier { unsigned* bar; unsigned x; volatile LAS unsigned* st; };
__device__ __forceinline__ XcdBarrier xcd_barrier_post(unsigned* bar, volatile LAS unsigned* st) {
    XcdBarrier b; b.bar = bar; b.x = xb_xcc_id(); b.st = st;
    if (threadIdx.x == 0) (void)xb_add(&bar[XB_XCNT(b.x)], 1u);
    return b;
}
__device__ __forceinline__ void xcd_barrier_complete(unsigned* bar, unsigned x, unsigned& nloc, unsigned& nx) {
    const unsigned G = gridDim.x * gridDim.y * gridDim.z;
    unsigned sum, cnt, mine, sp = 0u;
    for (;;) {
        sum = 0u; cnt = 0u; mine = 0u;
#pragma unroll
        for (unsigned j = 0; j < 16; ++j) { const unsigned c = xb_ld(&bar[XB_XCNT(j)]); sum += c; cnt += (c > 0u) ? 1u : 0u; mine = (j == x) ? c : mine; }
        if (sum == G) break;
        __builtin_amdgcn_s_sleep(1);
        if ((++sp & 255u) == 0u) { if (xb_ld(&bar[XB_TMO])) break; if (sp > XB_SPIN_CAP) { atomicAdd(&bar[XB_TMO], 1u); break; } }
    }
    nloc = mine > 0u ? mine : 1u; nx = cnt > 0u ? cnt : 1u;
}
__device__ __forceinline__ void xcd_barrier(const XcdBarrier& b) {
    asm volatile("s_waitcnt vmcnt(0)" ::: "memory");
    __syncthreads();
    if (threadIdx.x == 0) {
        unsigned* bar = b.bar;
        __builtin_amdgcn_s_waitcnt(0);
        unsigned nloc = b.st[0], nx = b.st[1];
        if (nloc == 0u) { xcd_barrier_complete(bar, b.x, nloc, nx); b.st[0] = nloc; b.st[1] = nx; }
#if XB_WG_RELEASE
        __builtin_amdgcn_fence(__ATOMIC_RELEASE, "agent");
        asm volatile("s_waitcnt vmcnt(0)" ::: "memory");
#endif
        const unsigned old = xb_add(&bar[XB_XSUB(b.x)], 1u);
        const unsigned gen = old / nloc;
        if (old + 1u == (gen + 1u) * nloc) {
            __builtin_amdgcn_fence(__ATOMIC_RELEASE, "agent");
            asm volatile("s_waitcnt vmcnt(0)" ::: "memory");
            const unsigned og = xb_add(&bar[XB_TOP], 1u);
            const unsigned tg = og / nx;
            if (og + 1u == (tg + 1u) * nx) xb_add(&bar[XB_TOPGEN], 1u);
            else XB_SPIN(xb_ld(&bar[XB_TOPGEN]) == tg, bar);
            __builtin_amdgcn_fence(__ATOMIC_ACQUIRE, "agent");
            xb_add(&bar[XB_XGEN(b.x)], 1u);
            asm volatile("s_waitcnt vmcnt(0)" ::: "memory");
        } else {
            XB_SPIN(xb_ld(&bar[XB_XGEN(b.x)]) == gen, bar);
            __builtin_amdgcn_fence(__ATOMIC_ACQUIRE, "agent");
            asm volatile("s_waitcnt vmcnt(0)" ::: "memory");
        }
    }
    __syncthreads();
}

struct Args { const float* in[N_IN]; float* out; unsigned char* ws; int ph_lo, ph_hi; };

struct Frame {
    LAS unsigned char* lds;
    int tid, lane, wave, bid, G;
    const float* const* in;
    float* out; unsigned char* ws;
};

__device__ __forceinline__ float wave_sum(float v) {
#pragma unroll
    for (int o = 1; o < 64; o <<= 1) v += __shfl_xor(v, o);
    return v;
}
__device__ __forceinline__ const float* xrow_ptr(const Frame& F, int m) {
    return m < MP ? F.in[0] + (size_t)m * DM : F.in[1] + (size_t)(m - MP) * DM;
}
__device__ __forceinline__ int row_cond(int m) { return m < MP ? 0 : 1 + ((m - MP) >> 10); }

__device__ __forceinline__ void p0_transpose_item(const float* W, int K, int N, bf16* WT, LAS float* scr, int item, int lane) {
    const int nblk = N / 32, kb = item / nblk, nb = item % nblk, k0 = 64 * kb, n0 = 32 * nb;
#pragma unroll 8
    for (int i = 0; i < 32; ++i) { const int kk = 2 * i + (lane >> 5); scr[kk * 33 + (lane & 31)] = W[(size_t)(k0 + kk) * N + n0 + (lane & 31)]; }
    LDS_WAIT(); asm volatile("" ::: "memory");
    const int c = lane & 7;
#pragma unroll
    for (int j = 0; j < 4; ++j) { const int n = (lane >> 3) + 8 * j; const LAS float* s = scr + (8 * c) * 33 + n;
        v4u o; o.x = pk2(s[0 * 33], s[1 * 33]); o.y = pk2(s[2 * 33], s[3 * 33]); o.z = pk2(s[4 * 33], s[5 * 33]); o.w = pk2(s[6 * 33], s[7 * 33]);
        *(GAS v4u*)(WT + (size_t)(n0 + n) * K + k0 + 8 * c) = o; }
    LDS_WAIT(); asm volatile("" ::: "memory");
}

__device__ __forceinline__ void p0_ada_item(Frame& F, int item) {
    LAS float* sc = (LAS float*)F.lds;
    LAS float* red = sc + 3 * 2048;
    const int l = item / 96, cb = item % 96;
    for (int i = F.tid; i < 3 * 2048; i += NWAVES * 64) { const int c = i >> 11, k = i & 2047; const float v = (c == 0) ? F.in[6][k] : F.in[5][(c - 1) * 2048 + k]; sc[i] = siluf(v); }
    __syncthreads();
    const float* W = F.in[l ? 14 : 8]; const float* bias = F.in[l ? 15 : 9];
    const int col = cb * 64 + F.lane, k0 = F.wave * 256;
    float a0 = 0.f, a1 = 0.f, a2 = 0.f;
    for (int k = 0; k < 256; k += 32) {
        float w[32];
#pragma unroll
        for (int i = 0; i < 32; ++i) w[i] = __builtin_nontemporal_load(W + (size_t)(k0 + k + i) * 6144 + col);
#pragma unroll
        for (int i = 0; i < 32; ++i) { a0 += sc[k0 + k + i] * w[i]; a1 += sc[2048 + k0 + k + i] * w[i]; a2 += sc[4096 + k0 + k + i] * w[i]; }
    }
    red[(F.wave * 3 + 0) * 64 + F.lane] = a0; red[(F.wave * 3 + 1) * 64 + F.lane] = a1; red[(F.wave * 3 + 2) * 64 + F.lane] = a2;
    __syncthreads();
    if (F.tid < 192) { const int c = F.tid >> 6, ln = F.tid & 63; float s = bias[cb * 64 + ln];
#pragma unroll
        for (int w = 0; w < 8; ++w) s += red[(w * 3 + c) * 64 + ln];
        ((float*)(F.ws + WS_ADA))[(l * 3 + c) * 6144 + cb * 64 + ln] = s; }
    __syncthreads();
}

__device__ __forceinline__ void s5_precompute_hook(Frame& F);
__device__ __forceinline__ void p0_transposes(Frame& F, int set, int rep);
__device__ __forceinline__ void p0_prologue(Frame& F, int rep) {
    if (F.bid < 192) p0_ada_item(F, F.bid);
    s5_precompute_hook(F);
    { const int gt = F.bid * (NWAVES * 64) + F.tid, NT = F.G * NWAVES * 64;
      for (int i = gt; i < 2 * (2 * 512 * 2048 / 8); i += NT) { const int which = i >= (2 * 512 * 2048 / 8); const int j = which ? i - (2 * 512 * 2048 / 8) : i;
          const float* src = F.in[which ? 3 : 2] + (size_t)j * 8; const f32x4 a = *(const f32x4*)src, b = *(const f32x4*)(src + 4);
          v4u o; o.x = pk2(a.x, a.y); o.y = pk2(a.z, a.w); o.z = pk2(b.x, b.y); o.w = pk2(b.z, b.w);
          *(v4u*)((bf16*)(F.ws + (which ? WS_CV : WS_CK)) + (size_t)j * 8) = o; } }
    p0_transposes(F, 0, rep);
}

__device__ __forceinline__ void p0_transposes(Frame& F, int set, int rep) {
    LAS float* scr = (LAS float*)(F.lds + F.wave * 16384);
    constexpr int I1 = (DM / 64) * (8192 / 32), I2 = (DM / 64) * (2048 / 32), I3 = (DM / 64) * (4096 / 32);
    static_assert(I1 % 8 == 0 && I2 % 8 == 0 && I3 % 8 == 0, "coarse queue items");
    const int nitems = set == 0 ? I1 + I2 : I3 + I2 + I2;
    unsigned* q = (unsigned*)(F.ws + WS_CTL) + CW_QUEUE + 16 * rep + 32 * set;
    for (;;) {
        int it8 = 0; if (F.lane == 0) it8 = (int)__hip_atomic_fetch_add(q, 1u, RLX_AGENT); it8 = __builtin_amdgcn_readfirstlane(it8);
        if (it8 * 8 >= nitems) break;
        for (int sub = 0; sub < 8; ++sub) {
            int r = it8 * 8 + sub;
            if (set == 0) {
                if (r < I1) { p0_transpose_item(F.in[10], DM, 8192, (bf16*)(F.ws + WS_W1), scr, r, F.lane); continue; } r -= I1;
                p0_transpose_item(F.in[12], DM, 2048, (bf16*)(F.ws + WS_W2), scr, r, F.lane);
            } else {
                if (r < I3) { p0_transpose_item(F.in[16], DM, 4096, (bf16*)(F.ws + WS_W3), scr, r, F.lane); continue; } r -= I3;
                if (r < I2) { p0_transpose_item(F.in[25], DM, 2048, (bf16*)(F.ws + WS_W4), scr, r, F.lane); continue; } r -= I2;
                p0_transpose_item(F.in[27], DM, 2048, (bf16*)(F.ws + WS_W5), scr, r, F.lane);
            }
        }
    }
}

template <bool FROM_INPUT>
__device__ __forceinline__ void norm_mod_rows(Frame& F, const float* xsrc, const float* g, const float* ada  , bf16* dst) {
    const int gw = F.bid * NWAVES + F.wave, NGW = F.G * NWAVES;
    for (int m = gw; m < MT; m += NGW) {
        const float* xr = FROM_INPUT ? xrow_ptr(F, m) : xsrc + (size_t)m * DM;
        const float* ad = ada + row_cond(m) * 6144;
        f32x4 v[8]; float s = 0.f;
#pragma unroll
        for (int j = 0; j < 8; ++j) { v[j] = *(const f32x4*)(xr + 4 * F.lane + 256 * j); s += (v[j].x * v[j].x + v[j].y * v[j].y) + (v[j].z * v[j].z + v[j].w * v[j].w); }
        const float rstd = 1.0f / sqrtf(wave_sum(s) * (1.f / DM) + EPS);
#pragma unroll
        for (int j = 0; j < 8; ++j) { const int c = 4 * F.lane + 256 * j;
            const f32x4 gg = *(const f32x4*)(g + c), sh = *(const f32x4*)(ad + c), sc = *(const f32x4*)(ad + 2048 + c);
            const f32x4 o = (v[j] * rstd) * gg * (sc + 1.0f) + sh;
            v2u w; w.x = pk2(o.x, o.y); w.y = pk2(o.z, o.w);
            *(v2u*)(dst + (size_t)m * DM + c) = w; }
    }
}

struct EpiL0In {
    static constexpr bool PERM = true;
    bf16 *QB, *KB, *VB, *SZ; float *outK, *outV; float qscale;
    __device__ __forceinline__ void operator()(const pg8::f32x4 (&acc)[2][2][4][2], const pg8::Unit& u, int wr, int wc, int fr, int fq) const {
        const int sec = u.pn >> 3, colt = (u.pn & 7) * 256;
        const int row0 = u.pm * 256 + wr * 64 + fr, col0 = colt + wc * 32 + 8 * fq;
        bf16* base = sec == 0 ? QB : sec == 1 ? KB : sec == 2 ? VB : SZ;
        float* fout = sec == 1 ? outK : outV;
        const bool wr32 = (sec == 1 || sec == 2) && (u.pm * 256 < MP);
#pragma unroll
        for (int ai = 0; ai < 2; ++ai)
#pragma unroll
            for (int m = 0; m < 4; ++m) { const size_t ro = (size_t)(row0 + ai * 128 + m * 16) * DM + col0;
#pragma unroll
                for (int bj = 0; bj < 2; ++bj) { f32x4 v0 = acc[ai][bj][m][0], v1 = acc[ai][bj][m][1];
                    if (wr32) { *(f32x4*)(fout + ro + bj * 128) = v0; *(f32x4*)(fout + ro + bj * 128 + 4) = v1; }
                    if (sec == 0) { v0 = v0 * qscale; v1 = v1 * qscale; }
                    if (sec == 3) {
#pragma unroll
                        for (int j = 0; j < 4; ++j) { v0[j] = siluf(v0[j]); v1[j] = siluf(v1[j]); } }
                    v4u w; w.x = pk2(v0[0], v0[1]); w.y = pk2(v0[2], v0[3]); w.z = pk2(v1[0], v1[1]); w.w = pk2(v1[2], v1[3]);
                    *(v4u*)(base + ro + bj * 128) = w; } }
    }
};

template <bool FROM_INPUT>
struct EpiResid {
    static constexpr bool PERM = true;
    const float* xp; const float* xs; float* xo; const float* gate3;
    __device__ __forceinline__ void operator()(const pg8::f32x4 (&acc)[2][2][4][2], const pg8::Unit& u, int wr, int wc, int fr, int fq) const {
        const int rowt = u.pm * 256, row0 = rowt + wr * 64 + fr, col0 = u.pn * 256 + wc * 32 + 8 * fq;
        const float* gv = gate3 + row_cond(rowt) * 6144 + 4096 + col0;
        f32x4 g4[2][2];
#pragma unroll
        for (int bj = 0; bj < 2; ++bj) { g4[bj][0] = *(const f32x4*)(gv + bj * 128); g4[bj][1] = *(const f32x4*)(gv + bj * 128 + 4); }
#pragma unroll
        for (int ai = 0; ai < 2; ++ai)
#pragma unroll
            for (int m = 0; m < 4; ++m) { const int row = row0 + ai * 128 + m * 16; const size_t ro = (size_t)row * DM + col0;
                const float* xin = FROM_INPUT ? (row < MP ? xp + ro : xs + (ro - (size_t)MP * DM)) : xo + ro;
#pragma unroll
                for (int bj = 0; bj < 2; ++bj) { const f32x4 x0 = *(const f32x4*)(xin + bj * 128), x1 = *(const f32x4*)(xin + bj * 128 + 4);
                    *(f32x4*)(xo + ro + bj * 128) = x0 + g4[bj][0] * acc[ai][bj][m][0]; *(f32x4*)(xo + ro + bj * 128 + 4) = x1 + g4[bj][1] * acc[ai][bj][m][1]; } }
    }
};
struct EpiL1In {
    static constexpr bool PERM = true;
    bf16 *UB, *SZ1;
    __device__ __forceinline__ void operator()(const pg8::f32x4 (&acc)[2][2][4][2], const pg8::Unit& u, int wr, int wc, int fr, int fq) const {
        const int sec = u.pn >> 3, colt = (u.pn & 7) * 256;
        const int row0 = u.pm * 256 + wr * 64 + fr, col0 = colt + wc * 32 + 8 * fq;
        bf16* base = sec == 0 ? UB : SZ1;
#pragma unroll
        for (int ai = 0; ai < 2; ++ai)
#pragma unroll
            for (int m = 0; m < 4; ++m) { const size_t ro = (size_t)(row0 + ai * 128 + m * 16) * DM + col0;
#pragma unroll
                for (int bj = 0; bj < 2; ++bj) { f32x4 v0 = acc[ai][bj][m][0], v1 = acc[ai][bj][m][1];
                    if (sec == 1) {
#pragma unroll
                        for (int j = 0; j < 4; ++j) { v0[j] = siluf(v0[j]); v1[j] = siluf(v1[j]); } }
                    v4u w; w.x = pk2(v0[0], v0[1]); w.y = pk2(v0[2], v0[3]); w.z = pk2(v1[0], v1[1]); w.w = pk2(v1[2], v1[3]);
                    *(v4u*)(base + ro + bj * 128) = w; } }
    }
};
struct EpiGlu {
    static constexpr bool PERM = true;
    const bf16 *YG, *SZ1; const float* bglu; bf16* Y2;
    __device__ __forceinline__ void operator()(const pg8::f32x4 (&acc)[2][2][4][2], const pg8::Unit& u, int wr, int wc, int fr, int fq) const {
        const int row0 = u.pm * 256 + wr * 64 + fr, col0 = u.pn * 256 + wc * 32 + 8 * fq;
        f32x4 b4[2][2];
#pragma unroll
        for (int bj = 0; bj < 2; ++bj) { b4[bj][0] = *(const f32x4*)(bglu + col0 + bj * 128); b4[bj][1] = *(const f32x4*)(bglu + col0 + bj * 128 + 4); }
#pragma unroll
        for (int ai = 0; ai < 2; ++ai)
#pragma unroll
            for (int m = 0; m < 4; ++m) { const size_t ro = (size_t)(row0 + ai * 128 + m * 16) * DM + col0;
#pragma unroll
                for (int bj = 0; bj < 2; ++bj) { const f32x4 t0 = acc[ai][bj][m][0] + b4[bj][0], t1 = acc[ai][bj][m][1] + b4[bj][1];
                    const v4u yv = *(const v4u*)(YG + ro + bj * 128), zv = *(const v4u*)(SZ1 + ro + bj * 128);
                    float o[8];
#pragma unroll
                    for (int j = 0; j < 8; ++j) { const unsigned yw = yv[j >> 1], zw = zv[j >> 1];
                        const float y = bf2f((unsigned short)((j & 1) ? (yw >> 16) : (yw & 0xffffu))), z = bf2f((unsigned short)((j & 1) ? (zw >> 16) : (zw & 0xffffu)));
                        const float t = j < 4 ? t0[j] : t1[j - 4];
                        o[j] = y * z / (1.0f + __expf(-t)); }
                    v4u w; w.x = pk2(o[0], o[1]); w.y = pk2(o[2], o[3]); w.z = pk2(o[4], o[5]); w.w = pk2(o[6], o[7]);
                    *(v4u*)(Y2 + ro + bj * 128) = w; } }
    }
};

__device__ __forceinline__ void final_norm_rows(Frame& F, float* X, const float* g) {
    const int gw = F.bid * NWAVES + F.wave, NGW = F.G * NWAVES;
    for (int m = gw; m < MT; m += NGW) {
        float* xr = X + (size_t)m * DM;
        f32x4 v[8]; float s = 0.f;
#pragma unroll
        for (int j = 0; j < 8; ++j) { v[j] = *(const f32x4*)(xr + 4 * F.lane + 256 * j); s += (v[j].x * v[j].x + v[j].y * v[j].y) + (v[j].z * v[j].z + v[j].w * v[j].w); }
        const float rstd = 1.0f / sqrtf(wave_sum(s) * (1.f / DM) + EPS);
#pragma unroll
        for (int j = 0; j < 8; ++j) { const int c = 4 * F.lane + 256 * j; const f32x4 gg = *(const f32x4*)(g + c);
            *(f32x4*)(xr + c) = (v[j] * rstd) * gg; }
    }
}

namespace att {
using f32x16 = __attribute__((ext_vector_type(16))) float;
using s16x4  = __attribute__((ext_vector_type(4))) short;
typedef short v4i16_t __attribute__((ext_vector_type(4)));
#define KSWZ(row, colB) ((row) * 256 + ((colB) ^ (((row) & 7) << 4)))
#define SBAR() __builtin_amdgcn_sched_barrier(0)
__device__ __forceinline__ int crow(int r, int hi) { return (r & 3) + 8 * (r >> 2) + 4 * hi; }
__device__ __forceinline__ int v_st(int k, int c) { const int kk = (k & ~0xC) | ((k & 4) << 1) | ((k & 8) >> 1); return ((kk >> 3) * 4 + (c >> 5)) * 512 + ((kk & 7) * 32 + (c & 31)) * 2; }
__device__ __forceinline__ int v_rd_base(int lane) { return ((lane & 3) << 3) | (((lane >> 2) & 3) << 6) | (((lane >> 4) & 1) << 5) | (((lane >> 5) & 1) << 8); }
constexpr int v_rd_off(int d0, int ks, int half) { return d0 * 512 + ks * 4096 + half * 2048; }
template <int OFF> __device__ __forceinline__ s16x4 tr_read(int vb) {
  s16x4 r; asm volatile("ds_read_b64_tr_b16 %0, %1 offset:%2" : "=&v"(r) : "v"(vb), "i"(OFF) : "memory"); return r;
}
__device__ __forceinline__ void qkt(f32x16& p0, f32x16& p1, const LAS unsigned char* Ks, const bf16x8* qr, int r32, int hi) {
  p0 = f32x16{}; p1 = f32x16{};
#pragma unroll
  for (int d0 = 0; d0 < 8; ++d0) { const int cb = (d0 * 16 + hi * 8) * 2;
    const bf16x8 b0 = *(const LAS bf16x8*)(Ks + KSWZ(r32, cb));
    const bf16x8 b1 = *(const LAS bf16x8*)(Ks + KSWZ(32 + r32, cb));
    p0 = __builtin_amdgcn_mfma_f32_32x32x16_bf16(b0, qr[d0], p0, 0, 0, 0);
    p1 = __builtin_amdgcn_mfma_f32_32x32x16_bf16(b1, qr[d0], p1, 0, 0, 0); }
}
template <int D0> __device__ __forceinline__ void pv_one(f32x16& od, int vb, bf16x8 pa0, bf16x8 pa1, bf16x8 pa2, bf16x8 pa3) {
  const s16x4 l0 = tr_read<v_rd_off(D0, 0, 0)>(vb), h0 = tr_read<v_rd_off(D0, 0, 1)>(vb), l1 = tr_read<v_rd_off(D0, 1, 0)>(vb), h1 = tr_read<v_rd_off(D0, 1, 1)>(vb);
  const s16x4 l2 = tr_read<v_rd_off(D0, 2, 0)>(vb), h2 = tr_read<v_rd_off(D0, 2, 1)>(vb), l3 = tr_read<v_rd_off(D0, 3, 0)>(vb), h3 = tr_read<v_rd_off(D0, 3, 1)>(vb);
  asm volatile("s_waitcnt lgkmcnt(0)" ::: "memory"); SBAR();
#define PK(L, H) (bf16x8){L[0], L[1], L[2], L[3], H[0], H[1], H[2], H[3]}
  od = __builtin_amdgcn_mfma_f32_32x32x16_bf16(pa0, PK(l0, h0), od, 0, 0, 0);
  od = __builtin_amdgcn_mfma_f32_32x32x16_bf16(pa1, PK(l1, h1), od, 0, 0, 0);
  od = __builtin_amdgcn_mfma_f32_32x32x16_bf16(pa2, PK(l2, h2), od, 0, 0, 0);
  od = __builtin_amdgcn_mfma_f32_32x32x16_bf16(pa3, PK(l3, h3), od, 0, 0, 0);
#undef PK
}
constexpr int L_K = 0, L_V = 16384, L_WS = 32768, L_RPB = 34816, L_OST = 40960, OST_LD = 68;

__device__ __forceinline__ void unit(Frame& F, int lat, int b, int h, int rq) {
  const int tid = F.tid, wid = F.wave, lane = F.lane, r32 = lane & 31, hi = lane >> 5;
  const bf16* QB = (const bf16*)(F.ws + WS_QB); const bf16* KB = (const bf16*)(F.ws + WS_KB); const bf16* VB = (const bf16*)(F.ws + WS_VB);
  const bf16* CK = (const bf16*)(F.ws + WS_CK); const bf16* CV = (const bf16*)(F.ws + WS_CV); const bf16* SZ = (const bf16*)(F.ws + WS_SZ);
  bf16* A2 = (bf16*)(F.ws + WS_ACTA);
  const LAS unsigned char* K_lds = F.lds + L_K; const LAS unsigned char* V_lds = F.lds + L_V;
  LAS float* wsf = (LAS float*)(F.lds + L_WS) + wid * 64; LAS float* rpb = (LAS float*)(F.lds + L_RPB);
  const int q0 = lat ? (MP + b * 1024 + rq * 256) : b * 256;
  const int hc = h * HD;
  int klo = 0, nloc = 0;
  if (lat) { const int r0a = min(max(4 * rq - 4, 0), 8), r0b = min(max(4 * rq + 3 - 4, 0), 8); klo = r0a; nloc = r0b + 8 - r0a; }
  const int ntiles = lat ? 8 + nloc : 4;
  const int R = 4 * rq + (wid >> 1), r0w = min(max(R - 4, 0), 8);
  const int qc = (wid & 1) * 32 + r32, c0 = min(max(qc - 8, 0), 48);
  __syncthreads();
  if (lat) { for (int i = tid; i < 15 * 31; i += NWAVES * 64) rpb[i] = F.in[11][h * 465 + i] * 1.4426950408889634f; }
  bf16x8 qr[8];
  { const bf16* Qw = QB + (size_t)(q0 + wid * 32 + r32) * DM + hc + hi * 8;
#pragma unroll
    for (int d0 = 0; d0 < 8; ++d0) qr[d0] = *(const bf16x8*)(Qw + d0 * 16); }
  const int sr = tid >> 4, sc = (tid & 15) * 8, vst0 = v_st(sr, sc), vst1 = v_st(32 + sr, sc);
  const int vb0 = (int)(uintptr_t)(F.lds + L_V) + v_rd_base(lane);
  float m_reg = -1e30f, l_reg = 0.f; f32x16 o[4] = {};
  auto tile_src = [&](int t, const bf16*& Kt, const bf16*& Vt, int& kr, bool& local) {
    kr = 0; local = false;
    if (!lat) { const size_t off = (size_t)(b * 256 + t * 64) * DM + hc; Kt = KB + off; Vt = VB + off; }
    else if (t < 8) { const size_t off = (size_t)(b * 512 + t * 64) * DM + hc; Kt = CK + off; Vt = CV + off; }
    else { kr = klo + (t - 8); local = true; const size_t off = (size_t)(MP + b * 1024 + kr * 64) * DM + hc; Kt = KB + off; Vt = VB + off; }
  };
  bf16x8 k0v, k1v, v0v, v1v;
  { const bf16 *Kt, *Vt; int kr_; bool loc_; tile_src(0, Kt, Vt, kr_, loc_);
    k0v = *(const bf16x8*)(Kt + (size_t)sr * DM + sc); k1v = *(const bf16x8*)(Kt + (size_t)(32 + sr) * DM + sc);
    v0v = *(const bf16x8*)(Vt + (size_t)sr * DM + sc); v1v = *(const bf16x8*)(Vt + (size_t)(32 + sr) * DM + sc); }
  *(LAS bf16x8*)(F.lds + L_K + KSWZ(sr, sc * 2)) = k0v; *(LAS bf16x8*)(F.lds + L_K + KSWZ(32 + sr, sc * 2)) = k1v;
  *(LAS bf16x8*)(F.lds + L_V + vst0) = v0v; *(LAS bf16x8*)(F.lds + L_V + vst1) = v1v;
  __syncthreads();
  for (int t = 0; t < ntiles; ++t) {
    int kr; bool local; { const bf16 *Kt_, *Vt_; tile_src(t, Kt_, Vt_, kr, local); }
    if (t + 1 < ntiles) { const bf16 *Kt, *Vt; int kr_; bool loc_; tile_src(t + 1, Kt, Vt, kr_, loc_);
      k0v = *(const bf16x8*)(Kt + (size_t)sr * DM + sc); k1v = *(const bf16x8*)(Kt + (size_t)(32 + sr) * DM + sc);
      v0v = *(const bf16x8*)(Vt + (size_t)sr * DM + sc); v1v = *(const bf16x8*)(Vt + (size_t)(32 + sr) * DM + sc); }
    const bool active = !local || (kr >= r0w && kr < r0w + 8);
    if (active) {
      f32x16 p0, p1;
      qkt(p0, p1, K_lds, qr, r32, hi);
      if (local) {
        const int rb = (kr - R + 7) * 31 + 15 - qc;
#pragma unroll
        for (int r = 0; r < 16; ++r) { const int ka = crow(r, hi), kb2 = 32 + ka;
          p0[r] = (ka >= c0 && ka < c0 + 16) ? p0[r] + rpb[rb + ka] : -1e30f;
          p1[r] = (kb2 >= c0 && kb2 < c0 + 16) ? p1[r] + rpb[rb + kb2] : -1e30f; }
      }
      float pmax = p0[0];
#pragma unroll
      for (int r = 1; r < 16; ++r) pmax = fmaxf(pmax, p0[r]);
#pragma unroll
      for (int r = 0; r < 16; ++r) pmax = fmaxf(pmax, p1[r]);
      { auto rr = __builtin_amdgcn_permlane32_swap(__float_as_uint(pmax), __float_as_uint(pmax), false, false);
        pmax = fmaxf(__uint_as_float(rr[0]), __uint_as_float(rr[1])); }
      const float mn = fmaxf(m_reg, pmax); const float alpha = __builtin_amdgcn_exp2f(m_reg - mn); m_reg = mn;
      float ps = 0.f;
#pragma unroll
      for (int r = 0; r < 16; ++r) { p0[r] = __builtin_amdgcn_exp2f(p0[r] - mn); p1[r] = __builtin_amdgcn_exp2f(p1[r] - mn); ps += p0[r] + p1[r]; }
      { auto rr = __builtin_amdgcn_permlane32_swap(__float_as_uint(ps), __float_as_uint(ps), false, false);
        ps = __uint_as_float(rr[0]) + __uint_as_float(rr[1]); }
      l_reg = l_reg * alpha + ps;
      bf16x8 pa0, pa1, pa2, pa3;
#define PK4(P, BASE, OUT) do { unsigned a0 = pk2(P[BASE + 0], P[BASE + 1]), a1 = pk2(P[BASE + 2], P[BASE + 3]);   \
    unsigned b0 = pk2(P[BASE + 4], P[BASE + 5]), b1 = pk2(P[BASE + 6], P[BASE + 7]);                              \
    auto r0_ = __builtin_amdgcn_permlane32_swap(a0, b0, false, false); auto r1_ = __builtin_amdgcn_permlane32_swap(a1, b1, false, false); \
    v4u w_ = {r0_[0], r1_[0], r0_[1], r1_[1]}; OUT = __builtin_bit_cast(bf16x8, w_); } while (0)
      PK4(p0, 0, pa0); PK4(p0, 8, pa1); PK4(p1, 0, pa2); PK4(p1, 8, pa3);
#undef PK4
      if (hi == 0) wsf[r32] = alpha;
      asm volatile("s_waitcnt lgkmcnt(0)" ::: "memory");
#pragma unroll
      for (int r = 0; r < 16; ++r) { const float al = wsf[crow(r, hi)];
#pragma unroll
        for (int d = 0; d < 4; ++d) o[d][r] *= al; }
      pv_one<0>(o[0], vb0, pa0, pa1, pa2, pa3); pv_one<1>(o[1], vb0, pa0, pa1, pa2, pa3);
      pv_one<2>(o[2], vb0, pa0, pa1, pa2, pa3); pv_one<3>(o[3], vb0, pa0, pa1, pa2, pa3);
    }

    __syncthreads();
    if (t + 1 < ntiles) {
      *(LAS bf16x8*)(F.lds + L_K + KSWZ(sr, sc * 2)) = k0v; *(LAS bf16x8*)(F.lds + L_K + KSWZ(32 + sr, sc * 2)) = k1v;
      *(LAS bf16x8*)(F.lds + L_V + vst0) = v0v; *(LAS bf16x8*)(F.lds + L_V + vst1) = v1v; }
    __syncthreads();
  }
  asm volatile("s_waitcnt lgkmcnt(0)" ::: "memory");
  if (hi == 0) wsf[32 + r32] = l_reg;
  asm volatile("s_waitcnt lgkmcnt(0)" ::: "memory");
  float rl[16];
#pragma unroll
  for (int r = 0; r < 16; ++r) rl[r] = __builtin_amdgcn_rcpf(wsf[32 + crow(r, hi)]);
  { LAS float* ost = (LAS float*)(F.lds + L_OST) + wid * (32 * OST_LD);
    const int er = lane >> 3, ec = (lane & 7) * 8;
#pragma unroll
    for (int hh = 0; hh < 2; ++hh) {
#pragma unroll
      for (int r = 0; r < 16; ++r) { const int orow = crow(r, hi);
        ost[orow * OST_LD + r32] = o[2 * hh][r] * rl[r]; ost[orow * OST_LD + 32 + r32] = o[2 * hh + 1][r] * rl[r]; }
      asm volatile("s_waitcnt lgkmcnt(0)" ::: "memory");
#pragma unroll
      for (int j = 0; j < 4; ++j) { const int row = er + 8 * j;
        const f32x4 a = *(const LAS f32x4*)(ost + row * OST_LD + ec), c4 = *(const LAS f32x4*)(ost + row * OST_LD + ec + 4);
        const size_t ro = (size_t)(q0 + wid * 32 + row) * DM + hc + hh * 64 + ec;
        const v4u zv = *(const v4u*)(SZ + ro);
        v4u w;
        w.x = pk2(a.x * bf2f((unsigned short)(zv.x & 0xffffu)), a.y * bf2f((unsigned short)(zv.x >> 16)));
        w.y = pk2(a.z * bf2f((unsigned short)(zv.y & 0xffffu)), a.w * bf2f((unsigned short)(zv.y >> 16)));
        w.z = pk2(c4.x * bf2f((unsigned short)(zv.z & 0xffffu)), c4.y * bf2f((unsigned short)(zv.z >> 16)));
        w.w = pk2(c4.z * bf2f((unsigned short)(zv.w & 0xffffu)), c4.w * bf2f((unsigned short)(zv.w >> 16)));
        *(v4u*)(A2 + ro) = w; }
      asm volatile("s_waitcnt lgkmcnt(0)" ::: "memory");
    } }
}

__device__ __forceinline__ void phase(Frame& F, int rep) {
  volatile LAS unsigned* MISC = (volatile LAS unsigned*)(F.lds + MISC_OFF);
  unsigned* q = (unsigned*)(F.ws + WS_CTL) + CW_QATT + 16 * rep;
  constexpr int NLAT = 2 * NH * 4, NCTX = 32 * NH, NU = NLAT + NCTX;
  for (;;) {
    if (F.tid == 0) MISC[0] = __hip_atomic_fetch_add(q, 1u, RLX_AGENT);
    __syncthreads();
    const int u = (int)MISC[0];
    __syncthreads();
    if (u >= NU + (PROBE_REP == 31 ? NCTX : 0) + (PROBE_REP == 32 ? NLAT : 0)) break;
    if (u >= NU) { if (PROBE_REP == 31) { const int j = u - NU; unit(F, 0, j >> 4, j & 15, 0); } else { const int v = u - NU; unit(F, 1, v >> 6, (v >> 2) & 15, v & 3); } continue; }
    if (u < NLAT) { const int rq = u & 3, h = (u >> 2) & 15, b = u >> 6; unit(F, 1, b, h, rq); }
    else { const int j = u - NLAT; unit(F, 0, j >> 4, j & 15, 0); }
  }
}
#undef KSWZ
#undef SBAR
}

namespace s5 {
using f32x16 = __attribute__((ext_vector_type(16))) float;
typedef short v4i16_t __attribute__((ext_vector_type(4)));
constexpr int IMG_ROW = 72;
constexpr int IMG_BYTES = 128 * IMG_ROW;

__device__ __forceinline__ void sincos_acc(float x, float& s, float& c) {
  const float k = rintf(x * 0.63661977236758134f);
  float r = fmaf(-k, 1.5707962512969971f, x); r = fmaf(-k, 7.5497894158615964e-08f, r); r = fmaf(-k, 5.3903029534742384e-15f, r);
  const float r2 = r * r;
  const float sp = r + r * r2 * (-1.6666654611e-1f + r2 * (8.3321608736e-3f + r2 * (-1.9515295891e-4f)));
  const float cp = 1.0f + r2 * (-0.5f + r2 * (4.166664568298827e-2f + r2 * (-1.388731625493765e-3f + r2 * 2.443315711809948e-5f)));
  const int q = ((int)k) & 3;
  const float ss = (q & 1) ? cp : sp, cc = (q & 1) ? sp : cp;
  s = (q & 2) ? -ss : ss; c = ((q + 1) & 2) ? -cc : cc;
}

__device__ __forceinline__ void precompute(Frame& F) {
  const int gw = F.bid * NWAVES + F.wave, NGW = F.G * NWAVES, lane = F.lane;
  bf16* SB = (bf16*)(F.ws + WS_S5B); bf16* SC = (bf16*)(F.ws + WS_S5C); float* SA = (float*)(F.ws + WS_S5A);
  for (int u = gw; u < 256; u += NGW) {
    const int d = u >> 7, g = u & 127, p = lane;
    const float dt = expf(F.in[19][d * 128 + g]);
    const float ar = F.in[17][(d * 128 + g) * 64 + p], ai = F.in[18][(d * 128 + g) * 64 + p];
    const float mag = expf(ar * dt); float sn, cs; sincos_acc(ai * dt, sn, cs);
    const float abr = mag * cs, abi = mag * sn;
    const float den = ar * ar + ai * ai, nr = abr - 1.0f;
    const float fre = (nr * ar + abi * ai) / den, fim = (abi * ar - nr * ai) / den;
    SA[((d * 128 + g) * 64 + p) * 2 + 0] = abr; SA[((d * 128 + g) * 64 + p) * 2 + 1] = abi;
    const float* bre = F.in[20] + ((size_t)(d * 128 + g) * 64 + p) * 16; const float* bim = F.in[21] + ((size_t)(d * 128 + g) * 64 + p) * 16;
    bf16* sb = SB + (size_t)(d * 128 + g) * 4 * 64 * 8;
#pragma unroll
    for (int c = 0; c < 16; ++c) { const float br = bre[c], bi = bim[c];
      const float vr = fre * br - fim * bi, vi = fre * bi + fim * br;
      const int l2 = (p & 31) + 32 * (c >> 3), j = c & 7, nb = 2 * (p >> 5);
      sb[((nb + 0) * 64 + l2) * 8 + j] = (bf16)f2bf(vr); sb[((nb + 1) * 64 + l2) * 8 + j] = (bf16)f2bf(vi); }
    const float* cre = F.in[22] + (size_t)(d * 128 + g) * 16 * 64; const float* cim = F.in[23] + (size_t)(d * 128 + g) * 16 * 64;
    bf16* scp = SC + (size_t)(d * 128 + g) * 4 * 64 * 8;
#pragma unroll
    for (int ks = 0; ks < 4; ++ks)
#pragma unroll
      for (int j = 0; j < 8; ++j) { const int c = lane & 15, pp = 32 * (ks >> 1) + 8 * (lane >> 4) + j;
        const float v = (ks & 1) ? -cim[c * 64 + pp] : cre[c * 64 + pp];
        scp[(ks * 64 + lane) * 8 + j] = (bf16)f2bf(v); }
  }
}


__device__ __forceinline__ void chunk_states(Frame& F) {
  if (F.wave >= 4) return;
  const int task = F.bid * 4 + F.wave; if (task >= 1024) return;
  const int lane = F.lane, half = lane >> 5, col = lane & 31;
  const int c = task & 3, d = (task >> 2) & 1, g = task >> 3;
  const bf16* UB = (const bf16*)(F.ws + WS_KB);
  bf16x8 Bf[4];
  { const bf16* sb = (const bf16*)(F.ws + WS_S5B) + (size_t)(d * 128 + g) * 4 * 64 * 8;
#pragma unroll
    for (int i = 0; i < 4; ++i) Bf[i] = *(const bf16x8*)(sb + (i * 64 + lane) * 8); }
  const float* SA = (const float*)(F.ws + WS_S5A) + (size_t)(d * 128 + g) * 64 * 2;
  const float a0r = SA[col * 2], a0i = SA[col * 2 + 1], a1r = SA[(32 + col) * 2], a1i = SA[(32 + col) * 2 + 1];
  float h0r = 0.f, h0i = 0.f, h1r = 0.f, h1i = 0.f;
  const int sA = (col >> 2) & 1, rA = (col & 3) + 4 * (col >> 3);
  const bf16* ubase = UB + (size_t)(MP + sA * 1024) * DM + g * 16 + 8 * half;
  const int t0 = d ? (1023 - 256 * c - rA) : (256 * c + rA), tstep = d ? -16 : 16;
  bf16x8 u[4];
#pragma unroll
  for (int i = 0; i < 4; ++i) u[i] = *(const bf16x8*)(ubase + (size_t)(t0 + i * tstep) * DM);
  for (int i4 = 0; i4 < 16; i4 += 4) {
    bf16x8 un[4];
#pragma unroll
    for (int i = 0; i < 4; ++i) un[i] = (i4 + 4 < 16) ? *(const bf16x8*)(ubase + (size_t)(t0 + (i4 + 4 + i) * tstep) * DM) : u[i];
#pragma unroll
    for (int i = 0; i < 4; ++i) {
      const f32x16 X0 = __builtin_amdgcn_mfma_f32_32x32x16_bf16(u[i], Bf[0], f32x16{}, 0, 0, 0);
      const f32x16 X1 = __builtin_amdgcn_mfma_f32_32x32x16_bf16(u[i], Bf[1], f32x16{}, 0, 0, 0);
      const f32x16 X2 = __builtin_amdgcn_mfma_f32_32x32x16_bf16(u[i], Bf[2], f32x16{}, 0, 0, 0);
      const f32x16 X3 = __builtin_amdgcn_mfma_f32_32x32x16_bf16(u[i], Bf[3], f32x16{}, 0, 0, 0);
#pragma unroll
      for (int r = 0; r < 16; ++r) {
        const float n0r = fmaf(a0r, h0r, fmaf(-a0i, h0i, X0[r])), n0i = fmaf(a0r, h0i, fmaf(a0i, h0r, X1[r]));
        const float n1r = fmaf(a1r, h1r, fmaf(-a1i, h1i, X2[r])), n1i = fmaf(a1r, h1i, fmaf(a1i, h1r, X3[r]));
        h0r = n0r; h0i = n0i; h1r = n1r; h1i = n1i; }
    }
#pragma unroll
    for (int i = 0; i < 4; ++i) u[i] = un[i];
  }
  float* sl = (float*)(F.ws + WS_S5L) + ((size_t)((d * 128 + g) * 4 + c) * 2 + half) * 128;
  sl[col] = h0r; sl[64 + col] = h0i; sl[32 + col] = h1r; sl[96 + col] = h1i;
}

__device__ __forceinline__ float gelu_tanh(float v) {
  const float u = 0.7978845608028654f * (v + 0.044715f * v * v * v);
  const float e = __expf(2.0f * u);
  const float th = 1.0f - 2.0f / (e + 1.0f);
  return 0.5f * v * (1.0f + th);
}

__device__ __forceinline__ void unit(Frame& F, int lat, int pj, int gq) {
  const int wid = F.wave, lane = F.lane, half = lane >> 5, col = lane & 31;
  const int g = 4 * gq + (wid & 3), d = wid >> 2;
  constexpr int L = 256, NT = L / 16;
  const bf16* UB = (const bf16*)(F.ws + WS_KB);
  float* YP = (float*)(F.ws + WS_ACTA);
  bf16* YG = (bf16*)(F.ws + WS_SZ);
  const LAS unsigned char* img = F.lds + wid * IMG_BYTES;
  const int rbase0 = lat ? MP + 256 * pj : (2 * pj) * 256, rbase1 = lat ? MP + 1024 + 256 * pj : (2 * pj + 1) * 256;
  bf16x8 Bf[4], Cf[4];
  { const bf16* sb = (const bf16*)(F.ws + WS_S5B) + (size_t)(d * 128 + g) * 4 * 64 * 8; const bf16* sc = (const bf16*)(F.ws + WS_S5C) + (size_t)(d * 128 + g) * 4 * 64 * 8;
#pragma unroll
    for (int i = 0; i < 4; ++i) { Bf[i] = *(const bf16x8*)(sb + (i * 64 + lane) * 8); Cf[i] = *(const bf16x8*)(sc + (i * 64 + lane) * 8); } }
  const float* SA = (const float*)(F.ws + WS_S5A) + (size_t)(d * 128 + g) * 64 * 2;
  const float a0r = SA[col * 2], a0i = SA[col * 2 + 1], a1r = SA[(32 + col) * 2], a1i = SA[(32 + col) * 2 + 1];
  float h0r = 0.f, h0i = 0.f, h1r = 0.f, h1i = 0.f;
  if (lat) { const float* st = F.in[4] + (size_t)((half * 2 + d) * 2) * 128 * 64 + (size_t)g * 64;
    h0r = st[col]; h1r = st[32 + col]; h0i = st[128 * 64 + col]; h1i = st[128 * 64 + 32 + col];
    const int nprev = d ? 3 - pj : pj;
    float p0r = a0r, p0i = a0i, p1r = a1r, p1i = a1i;
#pragma unroll
    for (int s = 0; s < 8; ++s) { const float t0 = p0r * p0r - p0i * p0i, u0 = 2.f * p0r * p0i, t1 = p1r * p1r - p1i * p1i, u1 = 2.f * p1r * p1i; p0r = t0; p0i = u0; p1r = t1; p1i = u1; }
    const float* SL = (const float*)(F.ws + WS_S5L) + (size_t)(d * 128 + g) * 4 * 2 * 128 + half * 128;
    for (int c = 0; c < nprev; ++c) { const float* sl = SL + c * 256;
      const float s0r = sl[col], s0i = sl[64 + col], s1r = sl[32 + col], s1i = sl[96 + col];
      const float n0r = p0r * h0r - p0i * h0i + s0r, n0i = p0r * h0i + p0i * h0r + s0i, n1r = p1r * h1r - p1i * h1i + s1r, n1i = p1r * h1i + p1i * h1r + s1i;
      h0r = n0r; h0i = n0i; h1r = n1r; h1i = n1i; } }
  const int sA = (col >> 2) & 1, rA = (col & 3) + 4 * (col >> 3);
  const bf16* ubase = UB + (size_t)(sA ? rbase1 : rbase0) * DM + g * 16 + 8 * half;
  const int tA0 = d ? (L - 1 - rA) : rA, tstep = d ? -16 : 16;
  const int tk = lane & 15, c0 = 4 * (lane >> 4);
  const int tR0 = d ? (L - 1 - tk) : tk;
  const f32x4 dsk = *(const f32x4*)(F.in[24] + g * 16 + c0);
  bf16x8 ucur = *(const bf16x8*)(ubase + (size_t)tA0 * DM);
  bf16x8 unext = ucur;
  if (1 < NT) unext = *(const bf16x8*)(ubase + (size_t)(tA0 + tstep) * DM);
  for (int i = 0; i < NT; ++i) {
    bf16x8 unext2 = unext;
    if (i + 2 < NT) unext2 = *(const bf16x8*)(ubase + (size_t)(tA0 + (i + 2) * tstep) * DM);
    if (i == NT / 2) { asm volatile("s_waitcnt vmcnt(0)" ::: "memory"); __syncthreads(); }
    const int t = tR0 + i * tstep;
    f32x4 oth[2]; v2u uuv[2];
    if (i >= NT / 2) {
#pragma unroll
      for (int hs = 0; hs < 2; ++hs) { const size_t off = (size_t)((hs ? rbase1 : rbase0) + t) * DM + g * 16 + c0;
        oth[hs] = __builtin_nontemporal_load((const f32x4*)(YP + off)); uuv[hs] = *(const v2u*)(UB + off); } }
    f32x16 X0 = __builtin_amdgcn_mfma_f32_32x32x16_bf16(ucur, Bf[0], f32x16{}, 0, 0, 0);
    f32x16 X1 = __builtin_amdgcn_mfma_f32_32x32x16_bf16(ucur, Bf[1], f32x16{}, 0, 0, 0);
    f32x16 X2 = __builtin_amdgcn_mfma_f32_32x32x16_bf16(ucur, Bf[2], f32x16{}, 0, 0, 0);
    f32x16 X3 = __builtin_amdgcn_mfma_f32_32x32x16_bf16(ucur, Bf[3], f32x16{}, 0, 0, 0);
#pragma unroll
    for (int r = 0; r < 16; ++r) {
      const float n0r = fmaf(a0r, h0r, fmaf(-a0i, h0i, X0[r])), n0i = fmaf(a0r, h0i, fmaf(a0i, h0r, X1[r]));
      const float n1r = fmaf(a1r, h1r, fmaf(-a1i, h1i, X2[r])), n1i = fmaf(a1r, h1i, fmaf(a1i, h1r, X3[r]));
      h0r = n0r; h0i = n0i; h1r = n1r; h1i = n1i; X0[r] = n0r; X1[r] = n0i; X2[r] = n1r; X3[r] = n1i;
    }
    { const LAS unsigned char* wp = img + col * IMG_ROW + half * 32;
#pragma unroll
      for (int q = 0; q < 4; ++q) {
        v2u w0, w1, w2, w3;
        w0.x = pk2(X0[4 * q], X0[4 * q + 1]); w0.y = pk2(X0[4 * q + 2], X0[4 * q + 3]);
        w1.x = pk2(X1[4 * q], X1[4 * q + 1]); w1.y = pk2(X1[4 * q + 2], X1[4 * q + 3]);
        w2.x = pk2(X2[4 * q], X2[4 * q + 1]); w2.y = pk2(X2[4 * q + 2], X2[4 * q + 3]);
        w3.x = pk2(X3[4 * q], X3[4 * q + 1]); w3.y = pk2(X3[4 * q + 2], X3[4 * q + 3]);
        *(LAS v2u*)(wp + 0 * 32 * IMG_ROW + q * 8) = w0; *(LAS v2u*)(wp + 1 * 32 * IMG_ROW + q * 8) = w1;
        *(LAS v2u*)(wp + 2 * 32 * IMG_ROW + q * 8) = w2; *(LAS v2u*)(wp + 3 * 32 * IMG_ROW + q * 8) = w3; } }
    asm volatile("s_waitcnt lgkmcnt(0)" ::: "memory");
    f32x4 yv[2];
#pragma unroll
    for (int hs = 0; hs < 2; ++hs) {
      f32x4 acc = {0.f, 0.f, 0.f, 0.f};
      const LAS unsigned char* rp = img + (8 * (lane >> 4) + ((lane >> 2) & 3)) * IMG_ROW + hs * 32 + (lane & 3) * 8;
#pragma unroll
      for (int ks = 0; ks < 4; ++ks) {
        const v4i16_t lo = __builtin_amdgcn_ds_read_tr16_b64_v4i16((LAS v4i16_t*)(rp + (32 * ks) * IMG_ROW));
        const v4i16_t hi4 = __builtin_amdgcn_ds_read_tr16_b64_v4i16((LAS v4i16_t*)(rp + (32 * ks + 4) * IMG_ROW));
        const bf16x8 bfr = (bf16x8){lo[0], lo[1], lo[2], lo[3], hi4[0], hi4[1], hi4[2], hi4[3]};
        acc = __builtin_amdgcn_mfma_f32_16x16x32_bf16(Cf[ks], bfr, acc, 0, 0, 0);
      }
      yv[hs] = acc;
    }
#pragma unroll
    for (int hs = 0; hs < 2; ++hs) {
      const size_t off = (size_t)((hs ? rbase1 : rbase0) + t) * DM + g * 16 + c0;
      if (i < NT / 2) { *(f32x4*)(YP + off) = yv[hs]; }
      else {
        const v2u uu = uuv[hs];
        f32x4 y = yv[hs] + oth[hs];
        y.x += dsk.x * bf2f((unsigned short)(uu.x & 0xffffu)); y.y += dsk.y * bf2f((unsigned short)(uu.x >> 16));
        y.z += dsk.z * bf2f((unsigned short)(uu.y & 0xffffu)); y.w += dsk.w * bf2f((unsigned short)(uu.y >> 16));
        v2u w; w.x = pk2(gelu_tanh(y.x), gelu_tanh(y.y)); w.y = pk2(gelu_tanh(y.z), gelu_tanh(y.w));
        *(v2u*)(YG + off) = w;
      }
    }
    ucur = unext; unext = unext2;
  }
  if (!lat) { float* ns = F.out + OUT_ST + (size_t)(((2 * pj + half) * 2 + d) * 2) * 128 * 64 + (size_t)g * 64;
    ns[col] = h0r; ns[32 + col] = h1r; ns[128 * 64 + col] = h0i; ns[128 * 64 + 32 + col] = h1i; }
}

__device__ __forceinline__ void phase(Frame& F, int rep) {
  volatile LAS unsigned* MISC = (volatile LAS unsigned*)(F.lds + MISC_OFF);
  unsigned* q = (unsigned*)(F.ws + WS_CTL) + CW_QS5 + 16 * rep;
  constexpr int NLAT = 4 * 32, NPR = 16 * 32, NU = NLAT + NPR;
  for (;;) {
    if (F.tid == 0) MISC[0] = __hip_atomic_fetch_add(q, 1u, RLX_AGENT);
    __syncthreads();
    const int u = (int)MISC[0];
    __syncthreads();
    if (u >= NU) break;
    if (u < NLAT) unit(F, 1, u >> 5, u & 31);
    else { const int j = u - NLAT; unit(F, 0, j >> 5, j & 31); }
  }
}
}

__device__ __forceinline__ void s5_precompute_hook(Frame& F) { s5::precompute(F); }
__global__ void __launch_bounds__(NWAVES * 64, 2) mk_fwd(Args args) {
    extern __shared__ __attribute__((aligned(16))) unsigned char lds_raw[];
    Frame F;
    F.lds = (LAS unsigned char*)lds_raw;
    F.tid = threadIdx.x; F.lane = F.tid & 63; F.wave = __builtin_amdgcn_readfirstlane(F.tid >> 6);
    F.bid = blockIdx.x; F.G = gridDim.x;
    F.in = args.in; F.out = args.out; F.ws = args.ws;
    volatile LAS unsigned* MISC = (volatile LAS unsigned*)(F.lds + MISC_OFF);
    for (int u = F.tid; u < (LDS_BYTES - RING_BYTES) / 4; u += NWAVES * 64) ((LAS unsigned*)(F.lds + RING_BYTES))[u] = 0u;
    __syncthreads();
    const int lo = args.ph_lo, hi = args.ph_hi;
    const bool one = (hi - lo) > 1;
    XcdBarrier bar; bar.bar = (unsigned*)(F.ws + WS_CTL) + CW_BAR; bar.x = 0; bar.st = nullptr;
    if (one) bar = xcd_barrier_post((unsigned*)(F.ws + WS_CTL) + CW_BAR, MISC + 8);
#define IN(k) (lo <= (k) && (k) < hi)
#define SEAM(k) do { if (IN(k) && IN((k) + 1)) xcd_barrier(bar); } while (0)
#define REP(k) for (int rep = 0; rep < ((PROBE_REP == (k)) ? 2 : 1); ++rep) if ((rep && one) ? (xcd_barrier(bar), true) : true)
    float* ADA = (float*)(F.ws + WS_ADA);


#ifdef L2TEST
    unsigned stale = 0;
    if (one) {
        v4u* T = (v4u*)(F.ws + WS_W1); constexpr int SL4 = (1 << 20) / 16;
        for (int round = 0; round < 8; ++round) {
            const unsigned val = 0x5000u + (unsigned)round * 0x01000000u;
            const int mine = (F.bid + round * 37) & 255, theirs = (F.bid + 97 + round * 37) & 255;
            for (int i = F.tid; i < SL4; i += NWAVES * 64) { const unsigned b = val + (unsigned)(mine * SL4 + i) * 4u; T[(size_t)mine * SL4 + i] = (v4u){b, b + 1u, b + 2u, b + 3u}; }
            xcd_barrier(bar);
            for (int i = F.tid; i < SL4; i += NWAVES * 64) { const unsigned b = val + (unsigned)(theirs * SL4 + i) * 4u; const v4u v = T[(size_t)theirs * SL4 + i];
                stale += (v.x != b) + (v.y != b + 1u) + (v.z != b + 2u) + (v.w != b + 3u); }
            xcd_barrier(bar);
        }
    }
#endif
    if (IN(0)) { { { const int rep = 0; (void)rep;  p0_prologue(F, rep);  }
        if (PROBE_REP == 0) { if (one) xcd_barrier(bar); const int rep = 1; (void)rep;  p0_prologue(F, rep);  } } SEAM(0); }
    if (IN(1)) { { { const int rep = 0; (void)rep;  norm_mod_rows<true>(F, nullptr, F.in[7], ADA, (bf16*)(F.ws + WS_ACTA));  }
        if (PROBE_REP == 1) { if (one) xcd_barrier(bar); const int rep = 1; (void)rep;  norm_mod_rows<true>(F, nullptr, F.in[7], ADA, (bf16*)(F.ws + WS_ACTA));  } } SEAM(1); }
    if (IN(2)) {
        { { const int rep = 0; (void)rep;
        pg8::Gemm g{(const bf16*)(F.ws + WS_ACTA), (const bf16*)(F.ws + WS_W1), MT, 8192, DM}; pg8::StaticOrder S; S.init(MT, 8192, F.G, F.bid);
        EpiL0In E{(bf16*)(F.ws + WS_QB), (bf16*)(F.ws + WS_KB), (bf16*)(F.ws + WS_VB), (bf16*)(F.ws + WS_SZ), F.out + OUT_NK, F.out + OUT_NV, 0.088388347648318440f * 1.4426950408889634f};
        pg8::gemm_phase<EpiL0In, pg8::StaticOrder, true, true>(F.lds, g, S, E);
         }
        if (PROBE_REP == 2) { if (one) xcd_barrier(bar); const int rep = 1; (void)rep;
        pg8::Gemm g{(const bf16*)(F.ws + WS_ACTA), (const bf16*)(F.ws + WS_W1), MT, 8192, DM}; pg8::StaticOrder S; S.init(MT, 8192, F.G, F.bid);
        EpiL0In E{(bf16*)(F.ws + WS_QB), (bf16*)(F.ws + WS_KB), (bf16*)(F.ws + WS_VB), (bf16*)(F.ws + WS_SZ), F.out + OUT_NK, F.out + OUT_NV, 0.088388347648318440f * 1.4426950408889634f};
        pg8::gemm_phase<EpiL0In, pg8::StaticOrder, true, true>(F.lds, g, S, E);
         } }
        SEAM(2);
    }
    if (IN(3)) { { { const int rep = 0; (void)rep;  att::phase(F, rep);  }
        if (PROBE_REP == 3) { if (one) xcd_barrier(bar); const int rep = 1; (void)rep;  att::phase(F, rep);  } } SEAM(3); }
    float* XRES = F.out + OUT_Y;
    if (IN(4)) {
        { { const int rep = 0; (void)rep;
        pg8::Gemm g{(const bf16*)(F.ws + WS_ACTA), (const bf16*)(F.ws + WS_W2), MT, DM, DM}; pg8::StaticOrder S; S.init(MT, DM, F.G, F.bid);
        EpiResid<true> E{F.in[0], F.in[1], XRES, ADA};
        pg8::gemm_phase<EpiResid<true>, pg8::StaticOrder, true, true>(F.lds, g, S, E);
        if (F.bid >= 64) p0_transposes(F, 1, 0);
         }
        if (PROBE_REP == 4) { if (one) xcd_barrier(bar); const int rep = 1; (void)rep;
        pg8::Gemm g{(const bf16*)(F.ws + WS_ACTA), (const bf16*)(F.ws + WS_W2), MT, DM, DM}; pg8::StaticOrder S; S.init(MT, DM, F.G, F.bid);
        EpiResid<true> E{F.in[0], F.in[1], XRES, ADA};
        pg8::gemm_phase<EpiResid<true>, pg8::StaticOrder, true, true>(F.lds, g, S, E);
         } }
        SEAM(4);
    }
    if (IN(5)) { { { const int rep = 0; (void)rep;  norm_mod_rows<false>(F, XRES, F.in[13], ADA + 3 * 6144, (bf16*)(F.ws + WS_QB));  }
        if (PROBE_REP == 5) { if (one) xcd_barrier(bar); const int rep = 1; (void)rep;  norm_mod_rows<false>(F, XRES, F.in[13], ADA + 3 * 6144, (bf16*)(F.ws + WS_QB));  } } SEAM(5); }
    if (IN(6)) {
        { { const int rep = 0; (void)rep;
        pg8::Gemm g{(const bf16*)(F.ws + WS_QB), (const bf16*)(F.ws + WS_W3), MT, 4096, DM}; pg8::StaticOrder S; S.init(MT, 4096, F.G, F.bid);
        EpiL1In E{(bf16*)(F.ws + WS_KB), (bf16*)(F.ws + WS_VB)};
        pg8::gemm_phase<EpiL1In, pg8::StaticOrder, true, true>(F.lds, g, S, E);
         }
        if (PROBE_REP == 6) { if (one) xcd_barrier(bar); const int rep = 1; (void)rep;
        pg8::Gemm g{(const bf16*)(F.ws + WS_QB), (const bf16*)(F.ws + WS_W3), MT, 4096, DM}; pg8::StaticOrder S; S.init(MT, 4096, F.G, F.bid);
        EpiL1In E{(bf16*)(F.ws + WS_KB), (bf16*)(F.ws + WS_VB)};
        pg8::gemm_phase<EpiL1In, pg8::StaticOrder, true, true>(F.lds, g, S, E);
         } }
        SEAM(6);
    }
    if (IN(7)) { s5::chunk_states(F); SEAM(7); }
    if (IN(8)) { { { const int rep = 0; (void)rep;  s5::phase(F, rep);  }
        if (PROBE_REP == 8) { if (one) xcd_barrier(bar); const int rep = 1; (void)rep;  s5::phase(F, rep);  } } SEAM(8); }
    if (IN(9)) {
        { { const int rep = 0; (void)rep;
        pg8::Gemm g{(const bf16*)(F.ws + WS_SZ), (const bf16*)(F.ws + WS_W4), MT, DM, DM}; pg8::StaticOrder S; S.init(MT, DM, F.G, F.bid);
        EpiGlu E{(const bf16*)(F.ws + WS_SZ), (const bf16*)(F.ws + WS_VB), F.in[26], (bf16*)(F.ws + WS_ACTA)};
        pg8::gemm_phase<EpiGlu, pg8::StaticOrder, true, true>(F.lds, g, S, E);
         }
        if (PROBE_REP == 9) { if (one) xcd_barrier(bar); const int rep = 1; (void)rep;
        pg8::Gemm g{(const bf16*)(F.ws + WS_SZ), (const bf16*)(F.ws + WS_W4), MT, DM, DM}; pg8::StaticOrder S; S.init(MT, DM, F.G, F.bid);
        EpiGlu E{(const bf16*)(F.ws + WS_SZ), (const bf16*)(F.ws + WS_VB), F.in[26], (bf16*)(F.ws + WS_ACTA)};
        pg8::gemm_phase<EpiGlu, pg8::StaticOrder, true, true>(F.lds, g, S, E);
         } }
        SEAM(9);
    }
    if (IN(10)) {
        pg8::Gemm g{(const bf16*)(F.ws + WS_ACTA), (const bf16*)(F.ws + WS_W5), MT, DM, DM}; pg8::StaticOrder S; S.init(MT, DM, F.G, F.bid);
        EpiResid<false> E{nullptr, nullptr, XRES, ADA + 3 * 6144};
        pg8::gemm_phase<EpiResid<false>, pg8::StaticOrder, true, true>(F.lds, g, S, E);
        SEAM(10);
    }
    if (IN(11)) { final_norm_rows(F, XRES, F.in[28]); }

#ifdef L2TEST
    if (stale) { float* ns = F.out + OUT_ST; ns[F.tid] = __builtin_nanf(""); }
#endif
#undef IN
#undef SEAM
#undef REP
}

extern "C" void kernel_launch(void* const* d_in, const int* in_sizes, int n_in, void* d_out, int out_size, void* d_ws, size_t ws_size, hipStream_t stream) {
    static int grid = 0;
    if (grid == 0) {
        if (n_in != N_IN || ws_size < WS_END) { fprintf(stderr, "kernel_launch: unexpected n_in %d or ws_size %zu (need %zu)\n", n_in, ws_size, (size_t)WS_END); grid = -1; return; }
        int dev = 0, cus = 0;
        if (hipGetDevice(&dev) != hipSuccess || hipDeviceGetAttribute(&cus, hipDeviceAttributeMultiprocessorCount, dev) != hipSuccess) { grid = -1; return; }
        if (hipFuncSetAttribute((const void*)mk_fwd, hipFuncAttributeMaxDynamicSharedMemorySize, LDS_BYTES) != hipSuccess) { fprintf(stderr, "kernel_launch: hipFuncSetAttribute failed\n"); grid = -1; return; }
        int per_cu = 0;
        if (hipOccupancyMaxActiveBlocksPerMultiprocessor(&per_cu, (const void*)mk_fwd, NWAVES * 64, LDS_BYTES) != hipSuccess || per_cu < 1) { fprintf(stderr, "kernel_launch: occupancy query says %d blocks per CU\n", per_cu); grid = -1; return; }
        (void)hipGetLastError();
        grid = cus;
    }
    if (grid < 0) return;
    (void)hipMemsetAsync((char*)d_ws + WS_CTL, 0, CTL_ZERO_BYTES, stream);
    Args a{};
    for (int i = 0; i < N_IN; ++i) a.in[i] = (const float*)d_in[i];
    a.out = (float*)d_out; a.ws = (unsigned char*)d_ws;
#if MK_ONE_LAUNCH
    a.ph_lo = 0; a.ph_hi = NPHASE;
#if MK_COOP
    void* kargs[] = {&a};
    const hipError_t le = hipLaunchCooperativeKernel((const void*)mk_fwd, dim3(grid), dim3(NWAVES * 64), kargs, LDS_BYTES, stream);
    if (le != hipSuccess) fprintf(stderr, "kernel_launch: cooperative launch failed: %s\n", hipGetErrorString(le));
#else
    hipLaunchKernelGGL(mk_fwd, dim3(grid), dim3(NWAVES * 64), LDS_BYTES, stream, a);
#endif
#else
    for (int p = 0; p < NPHASE; ++p) { a.ph_lo = p; a.ph_hi = p + 1; hipLaunchKernelGGL(mk_fwd, dim3(grid), dim3(NWAVES * 64), LDS_BYTES, stream, a); }
#endif
}
```
